# Optimizing an MI355X kernel written in HIP

```python
import jax, jax.numpy as jnp
from jax import lax
import numpy as np

D_MODEL = 2048
BATCH = 2
SEQ = 8192
DEPTH = 2

CTX_LEN = 256
GRID_W = 64
Q_BLOCK = 128
ROPE_THETA = 10000.0
LN_EPS = 1e-6
RMS_EPS = 1e-6

A_HEADS = 4
A_DK = 64
A_DV = 128
A_CHUNK = 128
A_CONV = 3
B_HEADS = 8
B_KV = 2
B_HD = 128
C_HEADS = 4
C_Q_LORA = 512
C_KV_LORA = 256
C_NOPE = 128
C_ROPE = 64
C_VD = 128
N_GROUPS = 4
EXP_PER_GROUP = 4
N_EXPERTS = N_GROUPS * EXP_PER_GROUP
TOP_K = 2
D_EXPERT = 512

A_IN = 2 * A_HEADS * A_DK + A_HEADS * A_DV + 4 * A_HEADS + A_HEADS * A_DV
B_IN = B_HEADS * B_HD + 2 * B_KV * B_HD
C_IN = C_Q_LORA + C_KV_LORA + C_ROPE
IN_WIDTH = A_IN + B_IN + C_IN
MIX_WIDTH = A_HEADS * A_DV + B_HEADS * B_HD + C_HEADS * C_VD

kernel_name = 'hybrid_mlstm_gqa_mla_hmoe_dit_trunk'


def layer_norm(x, g, b):
    xf = x.astype(jnp.float32)
    mu = jnp.mean(xf, axis=-1, keepdims=True)
    var = jnp.mean(jnp.square(xf - mu), axis=-1, keepdims=True)
    return ((xf - mu) * lax.rsqrt(var + LN_EPS) * g + b).astype(x.dtype)


def rms_norm(x, g):
    xf = x.astype(jnp.float32)
    y = xf * lax.rsqrt(jnp.mean(jnp.square(xf), axis=-1, keepdims=True) + RMS_EPS)
    return (y * g).astype(x.dtype)


def axial_rope_tables(T, dim):
    rows = T // GRID_W
    row = jnp.repeat(jnp.arange(rows, dtype=jnp.float32), GRID_W)
    col = jnp.tile(jnp.arange(GRID_W, dtype=jnp.float32), rows)
    n_freq = dim // 4
    inv = ROPE_THETA ** (-jnp.arange(n_freq, dtype=jnp.float32) / n_freq)
    ang = jnp.concatenate([row[:, None] * inv, col[:, None] * inv], axis=-1)
    return jnp.cos(ang), jnp.sin(ang)


def apply_rope(x, rope):
    cos, sin = rope
    xf = x.astype(jnp.float32)
    half = x.shape[-1] // 2
    x1, x2 = xf[..., :half], xf[..., half:]
    cs, sn = cos[:, None, :], sin[:, None, :]
    return jnp.concatenate([x1 * cs - x2 * sn, x2 * cs + x1 * sn], axis=-1).astype(x.dtype)


def centred_dwconv(x, w, b):
    y = lax.conv_general_dilated(x, w[:, None, :].astype(x.dtype), window_strides=(1,), padding='SAME',
                                 dimension_numbers=('NWC', 'WIO', 'NWC'), feature_group_count=x.shape[-1])
    return y + b


def block_attention(q, k, v):
    Bn, T, Hk, G, d = q.shape
    nb = T // Q_BLOCK
    qb = jnp.moveaxis(q.reshape(Bn, nb, Q_BLOCK, Hk, G, d), 1, 0)
    scale = d ** -0.5

    def attend(qblk):
        s = jnp.einsum('bqhgd,bkhd->bhgqk', qblk, k).astype(jnp.float32) * scale
        p = jax.nn.softmax(s, axis=-1).astype(v.dtype)
        return jnp.einsum('bhgqk,bkhe->bqhge', p, v)

    o = lax.map(attend, qb)
    return jnp.moveaxis(o, 0, 1).reshape(Bn, T, Hk, G, v.shape[-1])


def mlstm_scan(q, k, v, ig, lf, state):
    Bn, H, T, _ = q.shape
    nc = T // A_CHUNK

    def chunks(a):
        return jnp.moveaxis(a.reshape(a.shape[:2] + (nc, A_CHUNK) + a.shape[3:]), 2, 0)

    upto = jnp.tril(jnp.ones((A_CHUNK, A_CHUNK), dtype=bool))

    def step(carry, xs):
        C, n, m = carry
        qc, kc, vc, ic, fc = xs
        b = jnp.cumsum(fc, axis=-1)
        g = b + m[..., None]
        d = jnp.where(upto, b[..., :, None] - b[..., None, :] + ic[..., None, :], -jnp.inf)
        mt = jnp.maximum(g, jnp.max(d, axis=-1))
        s = jnp.einsum('bhtd,bhsd->bhts', qc, kc) * jnp.exp(d - mt[..., None])
        w_prev = jnp.exp(g - mt)
        num = w_prev[..., None] * jnp.einsum('bhvd,bhtd->bhtv', C, qc) + jnp.einsum('bhts,bhsv->bhtv', s, vc)
        den = w_prev * jnp.einsum('bhd,bhtd->bht', n, qc) + jnp.sum(s, axis=-1)
        h = num / jnp.maximum(jnp.abs(den), jnp.exp(-mt))[..., None]
        b_last = b[..., -1]
        a = b_last[..., None] - b + ic
        m_new = jnp.maximum(b_last + m, jnp.max(a, axis=-1))
        w_k = jnp.exp(a - m_new[..., None])
        decay = jnp.exp(b_last + m - m_new)
        C_new = decay[..., None, None] * C + jnp.einsum('bhs,bhsv,bhsd->bhvd', w_k, vc, kc)
        n_new = decay[..., None] * n + jnp.einsum('bhs,bhsd->bhd', w_k, kc)
        return (C_new, n_new, m_new), h

    state, h = lax.scan(step, state, (chunks(q), chunks(k), chunks(v), chunks(ig), chunks(lf)))
    return state, jnp.moveaxis(h, 0, 2).reshape(Bn, H, T, -1)


def mlstm_group(z, zc, conv_w, conv_b, gate_b, norm_g, need_ctx):
    QK = 2 * A_HEADS * A_DK
    V = A_HEADS * A_DV
    G = 4 * A_HEADS

    def prep(zz):
        Bn, T, _ = zz.shape
        qk = jax.nn.silu(centred_dwconv(zz[..., :QK], conv_w, conv_b))
        q = qk[..., :QK // 2].reshape(Bn, T, A_HEADS, A_DK)
        k = qk[..., QK // 2:].reshape(Bn, T, A_HEADS, A_DK) * (A_DK ** -0.5)
        v = zz[..., QK:QK + V].reshape(Bn, T, A_HEADS, A_DV)
        gates = zz[..., QK + V:QK + V + G].reshape(Bn, T, 4, A_HEADS) + gate_b
        og = jax.nn.sigmoid(zz[..., QK + V + G:])
        ig_f, ig_b, fg_f, fg_b = jnp.transpose(gates.astype(jnp.float32), (2, 0, 3, 1))
        q, k, v = (jnp.moveaxis(a.astype(jnp.float32), 1, 2) for a in (q, k, v))
        fwd = (q, k, v, ig_f, jax.nn.log_sigmoid(fg_f))
        bwd = tuple(jnp.flip(a, axis=2) for a in (q, k, v, ig_b, jax.nn.log_sigmoid(fg_b)))
        return fwd, bwd, og

    fwd_c, bwd_c, og_c = prep(zc)
    fwd_l, bwd_l, og_l = prep(z)
    Bn = z.shape[0]
    zero = (jnp.zeros((Bn, A_HEADS, A_DV, A_DK), jnp.float32), jnp.zeros((Bn, A_HEADS, A_DK), jnp.float32),
            jnp.zeros((Bn, A_HEADS), jnp.float32))
    st_f, hc_f = mlstm_scan(*fwd_c, zero)
    st_b, hc_b = mlstm_scan(*bwd_c, zero)
    _, hl_f = mlstm_scan(*fwd_l, st_f)
    _, hl_b = mlstm_scan(*bwd_l, st_b)

    def finish(hf, hb_rev, og):
        hs = jnp.moveaxis(hf + jnp.flip(hb_rev, axis=2), 1, 2)
        mu = jnp.mean(hs, axis=-1, keepdims=True)
        var = jnp.mean(jnp.square(hs - mu), axis=-1, keepdims=True)
        hn = ((hs - mu) * lax.rsqrt(var + LN_EPS)).reshape(hs.shape[0], hs.shape[1], -1) * norm_g
        return (hn * og.astype(jnp.float32)).astype(og.dtype)

    y = finish(hl_f, hl_b, og_l)
    yc = finish(hc_f, hc_b, og_c) if need_ctx else None
    return y, yc


def gqa_group(z, zc, qn_g, kn_g, rope, need_ctx):
    QW = B_HEADS * B_HD
    KW = B_KV * B_HD

    def prep(zz, use_rope):
        Bn, T, _ = zz.shape
        q = rms_norm(zz[..., :QW].reshape(Bn, T, B_HEADS, B_HD), qn_g)
        k = rms_norm(zz[..., QW:QW + KW].reshape(Bn, T, B_KV, B_HD), kn_g)
        v = zz[..., QW + KW:].reshape(Bn, T, B_KV, B_HD)
        if use_rope:
            q = apply_rope(q, rope)
            k = apply_rope(k, rope)
        return q.reshape(Bn, T, B_KV, B_HEADS // B_KV, B_HD), k, v

    ql, kl, vl = prep(z, True)
    qc, kc, vc = prep(zc, False)
    Bn, T = z.shape[:2]
    y = block_attention(ql, jnp.concatenate([kc, kl], axis=1), jnp.concatenate([vc, vl], axis=1)).reshape(Bn, T, QW)
    yc = block_attention(qc, kc, vc).reshape(Bn, zc.shape[1], QW) if need_ctx else None
    return y, yc


def mla_group(z, zc, qa_g, w_uq, kva_g, w_ukv, rope, need_ctx):
    def prep(zz, use_rope):
        Bn, T, _ = zz.shape
        cq = rms_norm(zz[..., :C_Q_LORA], qa_g)
        q = (cq @ w_uq).reshape(Bn, T, C_HEADS, C_NOPE + C_ROPE)
        ckv = rms_norm(zz[..., C_Q_LORA:C_Q_LORA + C_KV_LORA], kva_g)
        kv = (ckv @ w_ukv).reshape(Bn, T, C_HEADS, C_NOPE + C_VD)
        q_nope, q_rope = q[..., :C_NOPE], q[..., C_NOPE:]
        k_nope, v = kv[..., :C_NOPE], kv[..., C_NOPE:]
        k_rope = zz[..., C_Q_LORA + C_KV_LORA:][:, :, None, :]
        if use_rope:
            q_rope = apply_rope(q_rope, rope)
            k_rope = apply_rope(k_rope, rope)
        qf = jnp.concatenate([q_nope, q_rope], axis=-1)[:, :, :, None, :]
        kf = jnp.concatenate([k_nope, jnp.broadcast_to(k_rope, (Bn, T, C_HEADS, C_ROPE))], axis=-1)
        return qf, kf, v

    ql, kl, vl = prep(z, True)
    qc, kc, vc = prep(zc, False)
    Bn, T = z.shape[:2]
    y = block_attention(ql, jnp.concatenate([kc, kl], axis=1), jnp.concatenate([vc, vl], axis=1)).reshape(Bn, T, C_HEADS * C_VD)
    yc = block_attention(qc, kc, vc).reshape(Bn, zc.shape[1], C_HEADS * C_VD) if need_ctx else None
    return y, yc


def mixing_sublayer(h, hc, w_in, a_conv_w, a_conv_b, a_gate_b, a_norm_g, b_qnorm_g, b_knorm_g,
                    c_qnorm_g, c_w_uq, c_kvnorm_g, c_w_ukv, w_out, rope_b, rope_c, need_ctx):
    z = h @ w_in
    zc = hc @ w_in
    sa, sb = A_IN, A_IN + B_IN
    ya, yac = mlstm_group(z[..., :sa], zc[..., :sa], a_conv_w, a_conv_b, a_gate_b, a_norm_g, need_ctx)
    yb, ybc = gqa_group(z[..., sa:sb], zc[..., sa:sb], b_qnorm_g, b_knorm_g, rope_b, need_ctx)
    ym, ymc = mla_group(z[..., sb:], zc[..., sb:], c_qnorm_g, c_w_uq, c_kvnorm_g, c_w_ukv, rope_c, need_ctx)
    y = jnp.concatenate([ya, yb, ym], axis=-1) @ w_out
    yc = jnp.concatenate([yac, ybc, ymc], axis=-1) @ w_out if need_ctx else None
    return y, yc


def hier_moe(t, w_rg, b_rg, w_re, b_re, e_gate, e_up, e_down):
    g_prob = jax.nn.softmax((t @ w_rg + b_rg).astype(jnp.float32), axis=-1)
    g_idx = jnp.argmax(g_prob, axis=-1)
    g_w = jnp.take_along_axis(g_prob, g_idx[:, None], axis=-1)
    e_logits = (t @ w_re + b_re).astype(jnp.float32).reshape(-1, N_GROUPS, EXP_PER_GROUP)
    e_in = jnp.take_along_axis(e_logits, g_idx[:, None, None], axis=1)[:, 0]
    top_v, top_i = lax.top_k(jax.nn.softmax(e_in, axis=-1), TOP_K)
    weights = g_w * top_v / jnp.sum(top_v, axis=-1, keepdims=True)
    expert_id = g_idx[:, None] * EXP_PER_GROUP + top_i
    combine = jnp.sum(jax.nn.one_hot(expert_id, N_EXPERTS, dtype=jnp.float32) * weights[..., None], axis=1).astype(t.dtype)
    y = jnp.zeros_like(t)
    for e in range(N_EXPERTS):
        hid = jax.nn.silu(t @ e_gate[e]) * (t @ e_up[e])
        y = y + (combine[:, e:e + 1] * hid) @ e_down[e]
    return y


def setup_inputs(seed: int = 0) -> dict:
    key = jax.random.key(seed)
    ks = list(jax.random.split(key, 32))
    L = DEPTH
    beta = (8.0 * DEPTH) ** -0.25

    def nrm(shape, scale):
        return jax.random.normal(ks.pop(), shape, jnp.float32) * scale

    def gain(shape):
        return 1.0 + nrm(shape, 0.02)

    ig_b = nrm((L, 2, A_HEADS), 0.1)
    fg_b = jnp.linspace(3.0, 6.0, A_HEADS, dtype=jnp.float32)[None, None, :] + nrm((L, 2, A_HEADS), 0.1)
    return {
        'x': nrm((BATCH, SEQ, D_MODEL), 1.0),
        'c': nrm((BATCH, D_MODEL), 1.0),
        'ctx': nrm((BATCH, CTX_LEN, D_MODEL), 1.0),
        'c_ctx': nrm((D_MODEL,), 1.0),
        'w_mod': nrm((L, D_MODEL, 6 * D_MODEL), 0.5 * D_MODEL ** -0.5),
        'b_mod': nrm((L, 6 * D_MODEL), 0.02),
        'w_in': nrm((L, D_MODEL, IN_WIDTH), D_MODEL ** -0.5),
        'a_conv_w': nrm((L, A_CONV, 2 * A_HEADS * A_DK), A_CONV ** -0.5),
        'a_conv_b': nrm((L, 2 * A_HEADS * A_DK), 0.02),
        'a_gate_b': jnp.concatenate([ig_b, fg_b], axis=1),
        'a_norm_g': gain((L, A_HEADS * A_DV)),
        'b_qnorm_g': gain((L, B_HD)),
        'b_knorm_g': gain((L, B_HD)),
        'c_qnorm_g': gain((L, C_Q_LORA)),
        'c_w_uq': nrm((L, C_Q_LORA, C_HEADS * (C_NOPE + C_ROPE)), C_Q_LORA ** -0.5),
        'c_kvnorm_g': gain((L, C_KV_LORA)),
        'c_w_ukv': nrm((L, C_KV_LORA, C_HEADS * (C_NOPE + C_VD)), C_KV_LORA ** -0.5),
        'w_out': nrm((L, MIX_WIDTH, D_MODEL), beta * MIX_WIDTH ** -0.5),
        'ln1_g': gain((L, D_MODEL)),
        'ln1_b': nrm((L, D_MODEL), 0.02),
        'ln2_g': gain((L, D_MODEL)),
        'ln2_b': nrm((L, D_MODEL), 0.02),
        'w_rg': nrm((L, D_MODEL, N_GROUPS), D_MODEL ** -0.5),
        'b_rg': nrm((L, N_GROUPS), 0.01),
        'w_re': nrm((L, D_MODEL, N_EXPERTS), D_MODEL ** -0.5),
        'b_re': nrm((L, N_EXPERTS), 0.01),
        'e_gate': nrm((L, N_EXPERTS, D_MODEL, D_EXPERT), D_MODEL ** -0.5),
        'e_up': nrm((L, N_EXPERTS, D_MODEL, D_EXPERT), D_MODEL ** -0.5),
        'e_down': nrm((L, N_EXPERTS, D_EXPERT, D_MODEL), beta * D_EXPERT ** -0.5),
    }


def reference(x, c, ctx, c_ctx, w_mod, b_mod, w_in, a_conv_w, a_conv_b, a_gate_b, a_norm_g, b_qnorm_g, b_knorm_g,
              c_qnorm_g, c_w_uq, c_kvnorm_g, c_w_ukv, w_out, ln1_g, ln1_b, ln2_g, ln2_b, w_rg, b_rg, w_re, b_re,
              e_gate, e_up, e_down):
    alpha = (2.0 * DEPTH) ** 0.25
    T = x.shape[1]
    D = x.shape[-1]
    rope_b = axial_rope_tables(T, B_HD)
    rope_c = axial_rope_tables(T, C_ROPE)
    xc = ctx
    for l in range(DEPTH):
        need_ctx = l < DEPTH - 1
        mod = [m[:, None, :] for m in jnp.split(jax.nn.silu(c) @ w_mod[l] + b_mod[l], 6, axis=-1)]
        mod_c = jnp.split(jax.nn.silu(c_ctx) @ w_mod[l] + b_mod[l], 6, axis=-1)
        h = x * (1.0 + mod[1]) + mod[0]
        hc = xc * (1.0 + mod_c[1]) + mod_c[0]
        y, yc = mixing_sublayer(h, hc, w_in[l], a_conv_w[l], a_conv_b[l], a_gate_b[l], a_norm_g[l], b_qnorm_g[l],
                                b_knorm_g[l], c_qnorm_g[l], c_w_uq[l], c_kvnorm_g[l], c_w_ukv[l], w_out[l],
                                rope_b, rope_c, need_ctx)
        x = layer_norm(alpha * x + mod[2] * y, ln1_g[l], ln1_b[l])
        h = x * (1.0 + mod[4]) + mod[3]
        n_lat = h.shape[0] * h.shape[1]
        if need_ctx:
            xc = layer_norm(alpha * xc + mod_c[2] * yc, ln1_g[l], ln1_b[l])
            hc = xc * (1.0 + mod_c[4]) + mod_c[3]
            tokens = jnp.concatenate([h.reshape(-1, D), hc.reshape(-1, D)], axis=0)
        else:
            tokens = h.reshape(-1, D)
        f = hier_moe(tokens, w_rg[l], b_rg[l], w_re[l], b_re[l], e_gate[l], e_up[l], e_down[l])
        x = layer_norm(alpha * x + mod[5] * f[:n_lat].reshape(x.shape), ln2_g[l], ln2_b[l])
        if need_ctx:
            xc = layer_norm(alpha * xc + mod_c[5] * f[n_lat:].reshape(xc.shape), ln2_g[l], ln2_b[l])
    return x
```

```cpp
#ifndef PROBE_REP
#define PROBE_REP -1
#endif
#ifndef PROBE_REPSUB
#define PROBE_REPSUB 0xff
#endif
#include <hip/hip_runtime.h>
#include <cstdio>
#include <cstdint>

#ifndef MK_N_LAUNCHES
#define MK_N_LAUNCHES 1
#endif

constexpr int D = 2048, NBATCH = 2, T = 8192, CTXL = 256, DEPTH = 2;
constexpr int NL = NBATCH * T;
constexpr int NC = NBATCH * CTXL;
constexpr int M = NL + NC;
constexpr int SKV = CTXL + T;
constexpr int INW = 3920, ZW = 4096;
constexpr int ZQG = 0, ZKG = 1024, ZVG = 1280, ZCQ = 1536, ZCKV = 2048, ZKR = 2304, ZGATE = 2368, ZMQ = 2384, ZMK = 2640, ZMV = 2896, ZOG = 3408;
constexpr int NEXP = 16, DEXP = 512;
constexpr int NCHUNK = 66;
constexpr float LN_EPS = 1e-6f, RMS_EPS = 1e-6f;
constexpr float ALPHA = 1.4142135623730951f;
constexpr int MAXSLOT = 37888;

constexpr size_t al256(size_t x) { return (x + 255) / 256 * 256; }
constexpr size_t WS_CTL = 0, CTL_BYTES = 1u << 20;
constexpr size_t WS_MOD = WS_CTL + CTL_BYTES;
constexpr size_t WS_ROPE = WS_MOD + al256((size_t)2 * 3 * 12288 * 4);
constexpr size_t WS_WIN = WS_ROPE + al256((size_t)18432 * 4);
constexpr size_t WS_WOUT = WS_WIN + (size_t)2 * ZW * D * 2;
constexpr size_t WS_WUQ = WS_WOUT + (size_t)2 * D * D * 2;
constexpr size_t WS_WUKV = WS_WUQ + (size_t)2 * 768 * 512 * 2;
constexpr size_t WS_WGU = WS_WUKV + (size_t)2 * 1024 * 256 * 2;
constexpr size_t WS_WD = WS_WGU + (size_t)NEXP * 1024 * D * 2;
constexpr size_t WS_HB = WS_WD + (size_t)NEXP * D * DEXP * 2;
constexpr size_t WS_Z = WS_HB + (size_t)M * D * 2;
constexpr size_t WS_QG = WS_Z + (size_t)M * ZW * 2;
constexpr size_t WS_KG = WS_QG + (size_t)M * 1024 * 2;
constexpr size_t WS_VG = WS_KG + (size_t)2 * 2 * SKV * 128 * 2;
constexpr size_t WS_CQ = WS_VG + (size_t)2 * 2 * SKV * 128 * 2;
constexpr size_t WS_CKV = WS_CQ + (size_t)M * 512 * 2;
constexpr size_t WS_QM = WS_CKV + (size_t)M * 256 * 2;
constexpr size_t WS_KM = WS_QM + (size_t)M * 768 * 2;
constexpr size_t WS_VM = WS_KM + (size_t)2 * 4 * SKV * 192 * 2;
constexpr size_t WS_U = WS_VM + (size_t)2 * 4 * SKV * 128 * 2;
constexpr size_t WS_UN = WS_U + (size_t)16 * NCHUNK * 8192 * 4;
constexpr size_t WS_USTAT = WS_UN + (size_t)16 * NCHUNK * 64 * 4;
constexpr size_t WS_CST = WS_USTAT + al256((size_t)16 * NCHUNK * 2 * 4);
constexpr size_t WS_NST = WS_CST + (size_t)16 * NCHUNK * 8192 * 2;
constexpr size_t WS_MST = WS_NST + (size_t)16 * NCHUNK * 64 * 4;
constexpr size_t WS_MIX = WS_MST + al256((size_t)16 * NCHUNK * 4);
constexpr size_t WS_XRES = WS_MIX + (size_t)M * D * 2;
constexpr size_t WS_LIST = WS_XRES + (size_t)M * D * 4;
constexpr size_t WS_ROWW = WS_LIST + (size_t)NEXP * M * 4;
constexpr size_t WS_TSLOT = WS_ROWW + (size_t)NEXP * M * 4;
constexpr size_t WS_WRT = WS_TSLOT + (size_t)M * 2 * 4;
constexpr size_t WS_END = WS_WRT + (size_t)2 * 2 * 32 * D * 2;
constexpr size_t WS_Y = WS_Z;
constexpr size_t WS_FSLOT = WS_Z;
constexpr size_t WS_HID = WS_MIX;
static_assert((size_t)MAXSLOT * D * 2 <= (size_t)M * ZW * 2 + (size_t)M * 1024 * 2, "fslot alias");
static_assert((size_t)MAXSLOT * DEXP * 2 <= (size_t)M * D * 2, "hid alias");
constexpr int CW_BAR = 4096;
constexpr int CW_CNT = 8192;
constexpr int CW_CHK = 8192 + 64;
constexpr int CW_FILL = 8192 + 128;

constexpr int LDS_BYTES = 147456;
constexpr int LDS_MISC = 147456 - 256;
constexpr int NWAVES = 8, NTHREADS = 512;

#define GAS __attribute__((address_space(1)))
#define LAS __attribute__((address_space(3)))
typedef unsigned short bf16;
typedef short bf16x8 __attribute__((ext_vector_type(8)));
typedef short s16x4 __attribute__((ext_vector_type(4)));
typedef float f32x4 __attribute__((ext_vector_type(4)));
typedef float f32x2 __attribute__((ext_vector_type(2)));
typedef float f32x8 __attribute__((ext_vector_type(8)));
typedef float f32x16 __attribute__((ext_vector_type(16)));
typedef unsigned u32x4 __attribute__((ext_vector_type(4)));
typedef unsigned u32x2 __attribute__((ext_vector_type(2)));
#define LDS_WAIT() asm volatile("s_waitcnt lgkmcnt(0)" ::: "memory")
#define VM_WAIT() asm volatile("s_waitcnt vmcnt(0)" ::: "memory")
#define SBAR() __builtin_amdgcn_sched_barrier(0)
#define LDS_BARRIER() do { asm volatile("s_waitcnt lgkmcnt(0)" ::: "memory"); __builtin_amdgcn_s_barrier(); asm volatile("" ::: "memory"); } while (0)

__device__ __forceinline__ int opaque_tid() { int t = threadIdx.x; asm volatile("" : "+v"(t)); return t; }
__device__ __forceinline__ unsigned cvtpk(float lo, float hi) { unsigned r; asm volatile("v_cvt_pk_bf16_f32 %0, %1, %2" : "=v"(r) : "v"(lo), "v"(hi)); return r; }
__device__ __forceinline__ float bf2f(unsigned short b) { return __uint_as_float((unsigned)b << 16); }
__device__ __forceinline__ float bflo(unsigned w) { return __uint_as_float(w << 16); }
__device__ __forceinline__ float bfhi(unsigned w) { return __uint_as_float(w & 0xffff0000u); }
__device__ __forceinline__ bf16 f2bf(float f) { return (bf16)(cvtpk(f, 0.f) & 0xffffu); }
__device__ __forceinline__ float wave_sum(float v) {
#pragma unroll
    for (int o = 1; o < 64; o <<= 1) v += __shfl_xor(v, o);
    return v;
}
__device__ __forceinline__ float sigmoidf_(float x) { return 1.f / (1.f + __expf(-x)); }
__device__ __forceinline__ float siluf_(float x) { return x / (1.f + __expf(-x)); }
__device__ __forceinline__ float logsigmoidf_(float x) { return fminf(x, 0.f) - log1pf(__expf(-fabsf(x))); }

#define XB_TMO      128
#define XB_XCNT(j)  (256  + 64 * (j))
#define XB_XSUB(j)  (1280 + 64 * (j))
#define XB_XGEN(j)  (2304 + 64 * (j))
#define XB_TOP      3328
#define XB_TOPGEN   3392
#define XCD_BAR_WORDS 3456
#define XB_SPIN_CAP (1u << 18)
__device__ __forceinline__ unsigned xb_ld(unsigned* p)              { return __hip_atomic_load(p, __ATOMIC_RELAXED, __HIP_MEMORY_SCOPE_AGENT); }
__device__ __forceinline__ unsigned xb_add(unsigned* p, unsigned v) { return __hip_atomic_fetch_add(p, v, __ATOMIC_RELAXED, __HIP_MEMORY_SCOPE_AGENT); }
__device__ __forceinline__ unsigned xb_xcc_id() { return (unsigned)__builtin_amdgcn_s_getreg((3 << 11) | 20) & 0xFu; }
#define XB_SPIN(cond, bar) do { unsigned _sp = 0; while (cond) { __builtin_amdgcn_s_sleep(1); \
    if ((++_sp & 255u) == 0u) { if (xb_ld(&(bar)[XB_TMO])) break; if (_sp > XB_SPIN_CAP) { atomicAdd(&(bar)[XB_TMO], 1u); break; } } } } while (0)
struct XcdBarrier { unsigned* bar; unsigned x; volatile LAS unsigned* st; };
__device__ __forceinline__ XcdBarrier xcd_barrier_post(unsigned* bar, volatile LAS unsigned* st) {
    XcdBarrier b; b.bar = bar; b.x = xb_xcc_id(); b.st = st;
    if (threadIdx.x == 0) (void)xb_add(&bar[XB_XCNT(b.x)], 1u);
    return b;
}
__device__ __forceinline__ void xcd_barrier_complete(unsigned* bar, unsigned x, unsigned& nloc, unsigned& nx) {
    const unsigned G = gridDim.x * gridDim.y * gridDim.z;
    unsigned sum, cnt, mine, sp = 0u;
    for (;;) {
        sum = 0u; cnt = 0u; mine = 0u;
#pragma nounroll
        for (unsigned j = 0; j < 16; ++j) { const unsigned c = xb_ld(&bar[XB_XCNT(j)]); sum += c; cnt += (c > 0u) ? 1u : 0u; mine = (j == x) ? c : mine; }
        if (sum == G) break;
        __builtin_amdgcn_s_sleep(1);
        if ((++sp & 255u) == 0u) { if (xb_ld(&bar[XB_TMO])) break; if (sp > XB_SPIN_CAP) { atomicAdd(&bar[XB_TMO], 1u); break; } }
    }
    nloc = mine > 0u ? mine : 1u; nx = cnt > 0u ? cnt : 1u;
}
__device__ __forceinline__ void xcd_barrier(const XcdBarrier& b) {
    asm volatile("s_waitcnt vmcnt(0)" ::: "memory");
    __syncthreads();
    if (threadIdx.x == 0) {
        unsigned* bar = b.bar; unsigned bx = b.x;
        asm volatile("" : "+s"(bar), "+s"(bx));
        __builtin_amdgcn_s_waitcnt(0);
        unsigned nloc = b.st[0], nx = b.st[1];
        if (nloc == 0u) { xcd_barrier_complete(bar, bx, nloc, nx); b.st[0] = nloc; b.st[1] = nx; }
        const unsigned old = xb_add(&bar[XB_XSUB(bx)], 1u);
        const unsigned gen = old / nloc;
        if (old + 1u == (gen + 1u) * nloc) {
            __builtin_amdgcn_fence(__ATOMIC_RELEASE, "agent");
            asm volatile("s_waitcnt vmcnt(0)" ::: "memory");
            const unsigned og = xb_add(&bar[XB_TOP], 1u);
            const unsigned tg = og / nx;
            if (og + 1u == (tg + 1u) * nx) xb_add(&bar[XB_TOPGEN], 1u);
            else XB_SPIN(xb_ld(&bar[XB_TOPGEN]) == tg, bar);
            __builtin_amdgcn_fence(__ATOMIC_ACQUIRE, "agent");
            xb_add(&bar[XB_XGEN(bx)], 1u);
            asm volatile("s_waitcnt vmcnt(0)" ::: "memory");
        } else {
            XB_SPIN(xb_ld(&bar[XB_XGEN(bx)]) == gen, bar);
            __builtin_amdgcn_fence(__ATOMIC_ACQUIRE, "agent");
            asm volatile("s_waitcnt vmcnt(0)" ::: "memory");
        }
    }
    __syncthreads();
}

namespace pg8 {
constexpr int BM = 256, BK = 64, HALF = 128, HTB = HALF * BK * 2, STAGE_BYTES = 8 * HTB;
__host__ __device__ __forceinline__ int lds_byte(int r, int c) { const int st = (r >> 4) * 2 + (c >> 5), rr = r & 15, cc = c & 31, ob = rr * 64 + cc * 2; return st * 1024 + (ob ^ (((ob >> 9) & 1) << 5)); }
__host__ __device__ __forceinline__ void stage_rc(int b, int& R, int& C) { const int st = b / 1024, sb = b % 1024, swz = sb ^ (((sb >> 9) & 1) << 5); R = (st >> 1) * 16 + swz / 64; C = (st & 1) * 32 + (swz % 64) / 2; }
__host__ __device__ __forceinline__ int perm32(int rho) { const int n = rho >> 4, i = rho & 15; return 8 * (i >> 2) + 4 * n + (i & 3); }

struct Unit { int pm, pn, e, j, ne, hf; };

struct DenseOrder {
    static constexpr bool GATHER = false;
    int nM, nN, nwg, G, c, K;
    __device__ void init(int Mrows, int N, int K_, int G_, int c_) { nM = Mrows / BM; nN = N / BM; nwg = nM * nN; G = G_; c = c_; K = K_; }
    __device__ void init_window(int Mrows, int N, int K_, int blk, int nb) { nM = Mrows / BM; nN = N / BM; nwg = (blk < nb) ? nM * nN : 0; G = nb; c = blk; K = K_; }
    __device__ bool next(int i, Unit& u) const {
        const long L = (long)i * G + c; if (L >= nwg) return false;
        int wgid = (int)L; { const int q = nwg / 8, r = nwg % 8, xcd = wgid % 8, off = wgid / 8; wgid = (xcd < r ? xcd * (q + 1) : r * (q + 1) + (xcd - r) * q) + off; }
        const int nig = 8 * nN, gid = wgid / nig, fm = gid * 8, gsz = (nM - fm) < 8 ? (nM - fm) : 8;
        u.pm = fm + ((wgid % nig) % gsz); u.pn = (wgid % nig) / gsz; u.e = 0; u.j = 0; u.ne = 0; u.hf = 0; return true;
    }
    __device__ __forceinline__ unsigned a_row(const Unit& u, int r) const { return (unsigned)(u.pm * BM + r); }
    __device__ __forceinline__ size_t b_off(const Unit& u) const { return (size_t)u.pn * BM * K * 2; }
};

struct TailOrder {
    static constexpr bool GATHER = false;
    int c, first, nb, pn, nM, K;
    __device__ bool next(int i, Unit& u) const { const int j = c - first; if (j < 0 || j >= nb) return false; const int pm = j + nb * i; if (pm >= nM) return false;
        u.pm = pm; u.pn = pn; u.e = 0; u.j = 0; u.ne = 0; u.hf = 0; return true; }
    __device__ __forceinline__ unsigned a_row(const Unit& u, int r) const { return (unsigned)(u.pm * BM + r); }
    __device__ __forceinline__ size_t b_off(const Unit& u) const { return (size_t)u.pn * BM * K * 2; }
};

template <class Epi, class Sched, int VAR = 0>
__device__ __forceinline__ void gemm_phase(LAS unsigned char* lds, const bf16* A, const bf16* Bt, const int K, const Sched& S, const Epi& E) {
    const int tid = opaque_tid(), wid = __builtin_amdgcn_readfirstlane(tid >> 6), lane = tid & 63, wr = wid >> 2, wc = wid & 3, fr = lane & 15, fq = lane >> 4;
    const int nt = K / BK;
    unsigned voffB[2], voffA[2];
    { int R0, C0, R1, C1; stage_rc(tid * 16, R0, C0); stage_rc(tid * 16 + 8192, R1, C1);
      const int Rb0 = Epi::PERM ? ((R0 & ~31) + perm32(R0 & 31)) : R0, Rb1 = Epi::PERM ? ((R1 & ~31) + perm32(R1 & 31)) : R1;
      voffB[0] = (unsigned)(Rb0 * K + C0) * 2u; voffB[1] = (unsigned)(Rb1 * K + C1) * 2u;
      voffA[0] = (unsigned)(R0 * K + C0) * 2u; voffA[1] = (unsigned)(R1 * K + C1) * 2u; }
    const size_t kstep = (size_t)(BK * 2);
    const size_t hstep = (size_t)HALF * K * 2;
    const unsigned ldsw = (unsigned)wid * 1024u;
    const int aoff = lds_byte(wr * 64 + fr, fq * 8), boff = lds_byte(wc * 32 + fr, fq * 8);
#define PG8_SA(b, h) (((b) * 2 + (h)) * HTB)
#define PG8_SB(b, h) ((4 + (b) * 2 + (h)) * HTB)
#define PG8_STAGEB(bufoff, gbase) do { \
        __builtin_amdgcn_global_load_lds((const unsigned*)((const char*)(gbase) + voffB[0]), (LAS unsigned*)(lds + (bufoff) + ldsw), 16, 0, 0); \
        __builtin_amdgcn_global_load_lds((const unsigned*)((const char*)(gbase) + voffB[1]), (LAS unsigned*)(lds + (bufoff) + ldsw + 8192), 16, 0, 0); } while (0)
#define PG8_STAGEA(bufoff, h, kb) do { \
        if constexpr (Sched::GATHER) { \
            __builtin_amdgcn_global_load_lds((const unsigned*)((const char*)A + (kb) + ((h) ? g10 : g00)), (LAS unsigned*)(lds + (bufoff) + ldsw), 16, 0, 0); \
            __builtin_amdgcn_global_load_lds((const unsigned*)((const char*)A + (kb) + ((h) ? g11 : g01)), (LAS unsigned*)(lds + (bufoff) + ldsw + 8192), 16, 0, 0); \
        } else { \
            __builtin_amdgcn_global_load_lds((const unsigned*)(cA + (h) * hstep + (kb) + voffA[0]), (LAS unsigned*)(lds + (bufoff) + ldsw), 16, 0, 0); \
            __builtin_amdgcn_global_load_lds((const unsigned*)(cA + (h) * hstep + (kb) + voffA[1]), (LAS unsigned*)(lds + (bufoff) + ldsw + 8192), 16, 0, 0); } } while (0)
#define PG8_LDA(dst, b, h) do { _Pragma("unroll") for (int m = 0; m < 4; ++m) _Pragma("unroll") for (int k = 0; k < 2; ++k) dst[m][k] = *(const LAS bf16x8*)(lds + PG8_SA(b, h) + aoff + m * 2048 + k * 1024); } while (0)
#define PG8_LDB(dst, b, h) do { _Pragma("unroll") for (int n = 0; n < 2; ++n) _Pragma("unroll") for (int k = 0; k < 2; ++k) dst[n][k] = *(const LAS bf16x8*)(lds + PG8_SB(b, h) + boff + n * 2048 + k * 1024); } while (0)
#define PG8_MMA(ai, bj, At, Bt_) do { __builtin_amdgcn_s_setprio(1); _Pragma("unroll") for (int m = 0; m < 4; ++m) _Pragma("unroll") for (int n = 0; n < 2; ++n) _Pragma("unroll") for (int k = 0; k < 2; ++k) \
        acc[ai][bj][m][n] = __builtin_amdgcn_mfma_f32_16x16x32_bf16(Bt_[n][k], At[m][k], acc[ai][bj][m][n], 0, 0, 0); __builtin_amdgcn_s_setprio(0); } while (0)
#define PG8_WAIT_V(n) asm volatile("s_waitcnt vmcnt(" #n ")" ::: "memory")
#define PG8_WAIT_L(n) asm volatile("s_waitcnt lgkmcnt(" #n ")" ::: "memory")
#define PG8_BAR __builtin_amdgcn_s_barrier()
#define PG8_SCHED __builtin_amdgcn_sched_barrier(0)
#define PG8_GOFF(u) do { int R0_, C0_, R1_, C1_; stage_rc(tid * 16, R0_, C0_); stage_rc(tid * 16 + 8192, R1_, C1_); \
        g00 = (S.a_row(u, R0_) * (unsigned)K + (unsigned)C0_) * 2u; g01 = (S.a_row(u, R1_) * (unsigned)K + (unsigned)C1_) * 2u; \
        g10 = (S.a_row(u, HALF + R0_) * (unsigned)K + (unsigned)C0_) * 2u; g11 = (S.a_row(u, HALF + R1_) * (unsigned)K + (unsigned)C1_) * 2u; } while (0)
    Unit cur, nxt; int ui = 0;
    if (!S.next(0, cur)) return;
    f32x4 acc[2][2][4][2];
#pragma unroll
    for (int a = 0; a < 2; ++a)
#pragma unroll
        for (int b = 0; b < 2; ++b)
#pragma unroll
            for (int m = 0; m < 4; ++m)
#pragma unroll
                for (int n = 0; n < 2; ++n) acc[a][b][m][n] = (f32x4){0.f, 0.f, 0.f, 0.f};
    bf16x8 At[4][2], B0[2][2], B1[2][2];
    unsigned g00 = 0, g01 = 0, g10 = 0, g11 = 0;
    const char* cA = (const char*)A;
    if constexpr (Sched::GATHER) { PG8_GOFF(cur); } else { cA = (const char*)A + (size_t)S.a_row(cur, 0) * K * 2; }
    const char* cB = (const char*)Bt + S.b_off(cur);
    PG8_STAGEB(PG8_SB(0, 0), cB); PG8_STAGEB(PG8_SB(0, 1), cB + hstep); PG8_STAGEA(PG8_SA(0, 0), 0, 0); PG8_STAGEA(PG8_SA(0, 1), 1, 0);
    if (wr == 1) PG8_BAR;
    PG8_WAIT_V(2); PG8_BAR;
    PG8_STAGEB(PG8_SB(1, 0), cB + kstep); PG8_STAGEA(PG8_SA(1, 0), 0, kstep); PG8_STAGEB(PG8_SB(1, 1), cB + hstep + kstep);
    PG8_WAIT_V(6); PG8_BAR;
    for (;;) {
        const bool has_next = S.next(ui + 1, nxt);
        const char* nB = has_next ? (const char*)Bt + S.b_off(nxt) : cB;
#pragma nounroll
        for (int t = 0; t < nt; t += 2) {
            const bool last = (t == nt - 2);
            const size_t k1 = (size_t)(t + 1) * kstep;
            const size_t k2 = last ? 0 : (size_t)(t + 2) * kstep, k3 = k2 + kstep;
            const char* b2 = last ? nB : cB + (size_t)(t + 2) * kstep; const char* b3 = b2 + kstep;
            PG8_LDB(B0, 0, 0); if constexpr (VAR != 1) PG8_LDB(B1, 0, 1); PG8_SCHED; PG8_LDA(At, 0, 0); PG8_STAGEA(PG8_SA(1, 1), 1, k1);
            PG8_WAIT_V(8); PG8_WAIT_L(0); PG8_BAR; PG8_MMA(0, 0, At, B0); if constexpr (VAR != 1) PG8_MMA(0, 1, At, B1); PG8_BAR; PG8_SCHED;
            if (last && has_next) { if constexpr (Sched::GATHER) { PG8_GOFF(nxt); } else { cA = (const char*)A + (size_t)S.a_row(nxt, 0) * K * 2; } }
            if constexpr (VAR != 2) PG8_LDA(At, 0, 1); PG8_STAGEB(PG8_SB(0, 0), b2); PG8_STAGEB(PG8_SB(0, 1), b2 + hstep); PG8_STAGEA(PG8_SA(0, 0), 0, k2);
            PG8_WAIT_V(8); PG8_WAIT_L(0); PG8_BAR; if constexpr (VAR != 2) { PG8_MMA(1, 0, At, B0); if constexpr (VAR != 1) PG8_MMA(1, 1, At, B1); } PG8_BAR; PG8_SCHED;
            PG8_LDB(B0, 1, 0); if constexpr (VAR != 1) PG8_LDB(B1, 1, 1); PG8_SCHED; PG8_LDA(At, 1, 0); PG8_STAGEA(PG8_SA(0, 1), 1, k2);
            PG8_WAIT_V(8); PG8_WAIT_L(0); PG8_BAR; PG8_MMA(0, 0, At, B0); if constexpr (VAR != 1) PG8_MMA(0, 1, At, B1); PG8_BAR; PG8_SCHED;
            if constexpr (VAR != 2) PG8_LDA(At, 1, 1); PG8_STAGEB(PG8_SB(1, 0), b3); PG8_STAGEB(PG8_SB(1, 1), b3 + hstep); PG8_STAGEA(PG8_SA(1, 0), 0, k3);
            PG8_WAIT_V(8); PG8_WAIT_L(0); PG8_BAR; if constexpr (VAR != 2) { PG8_MMA(1, 0, At, B0); if constexpr (VAR != 1) PG8_MMA(1, 1, At, B1); } PG8_BAR; PG8_SCHED;
        }
        if (wr == 0) PG8_BAR;
        { int fr_ = fr, fq_ = fq; asm volatile("" : "+v"(fr_), "+v"(fq_));
          E(acc, cur, wr, wc, fr_, fq_); }
        if (!has_next) break;
#pragma unroll
        for (int a = 0; a < 2; ++a)
#pragma unroll
            for (int b = 0; b < 2; ++b)
#pragma unroll
                for (int m = 0; m < 4; ++m)
#pragma unroll
                    for (int n = 0; n < 2; ++n) acc[a][b][m][n] = (f32x4){0.f, 0.f, 0.f, 0.f};
        cur = nxt; cB = nB; ++ui;
        if (wr == 1) PG8_BAR;
    }
    PG8_WAIT_V(0);
    PG8_BAR;
#undef PG8_SA
#undef PG8_SB
#undef PG8_STAGEA
#undef PG8_STAGEB
#undef PG8_LDA
#undef PG8_LDB
#undef PG8_MMA
#undef PG8_WAIT_V
#undef PG8_WAIT_L
#undef PG8_BAR
#undef PG8_SCHED
#undef PG8_GOFF
}
}

struct EpiStore {
    static constexpr bool PERM = true;
    bf16* O; int ldc;
    __device__ __forceinline__ void operator()(const f32x4 (&acc)[2][2][4][2], const pg8::Unit& u, int wr, int wc, int fr, int fq) const {
        const int row0 = u.pm * 256 + wr * 64 + fr, col0 = u.pn * 256 + wc * 32 + 8 * fq;
#pragma unroll
        for (int ai = 0; ai < 2; ++ai)
#pragma unroll
            for (int m = 0; m < 4; ++m) { bf16* rowp = O + (size_t)(row0 + ai * 128 + m * 16) * ldc + col0;
#pragma unroll
                for (int bj = 0; bj < 2; ++bj) { const f32x4 v0 = acc[ai][bj][m][0], v1 = acc[ai][bj][m][1];
                    u32x4 w; w.x = cvtpk(v0[0], v0[1]); w.y = cvtpk(v0[2], v0[3]); w.z = cvtpk(v1[0], v1[1]); w.w = cvtpk(v1[2], v1[3]);
                    *(u32x4*)(rowp + bj * 128) = w; } }
    }
};
struct EpiStoreHalfM {
    static constexpr bool PERM = true;
    bf16* O; int ldc;
    __device__ __forceinline__ void operator()(const f32x4 (&acc)[2][2][4][2], const pg8::Unit& u, int wr, int wc, int fr, int fq) const {
        const int row0 = u.pm * 256 + u.hf * 128 + wr * 64 + fr, col0 = u.pn * 256 + wc * 32 + 8 * fq;
#pragma unroll
        for (int m = 0; m < 4; ++m) { bf16* rowp = O + (size_t)(row0 + m * 16) * ldc + col0;
#pragma unroll
            for (int bj = 0; bj < 2; ++bj) { const f32x4 v0 = acc[0][bj][m][0], v1 = acc[0][bj][m][1];
                u32x4 w; w.x = cvtpk(v0[0], v0[1]); w.y = cvtpk(v0[2], v0[3]); w.z = cvtpk(v1[0], v1[1]); w.w = cvtpk(v1[2], v1[3]);
                *(u32x4*)(rowp + bj * 128) = w; } }
    }
};
struct EpiStoreHalf {
    static constexpr bool PERM = true;
    bf16* O; int ldc;
    __device__ __forceinline__ void operator()(const f32x4 (&acc)[2][2][4][2], const pg8::Unit& u, int wr, int wc, int fr, int fq) const {
        const int row0 = u.pm * 256 + wr * 64 + fr, col0 = u.pn * 256 + wc * 32 + 8 * fq;
#pragma unroll
        for (int ai = 0; ai < 2; ++ai)
#pragma unroll
            for (int m = 0; m < 4; ++m) { bf16* rowp = O + (size_t)(row0 + ai * 128 + m * 16) * ldc + col0;
                const f32x4 v0 = acc[ai][0][m][0], v1 = acc[ai][0][m][1];
                u32x4 w; w.x = cvtpk(v0[0], v0[1]); w.y = cvtpk(v0[2], v0[3]); w.z = cvtpk(v1[0], v1[1]); w.w = cvtpk(v1[2], v1[3]);
                *(u32x4*)rowp = w; }
    }
};
constexpr float MLA_QS = 0.10411740f;
struct EpiQmla {
    static constexpr bool PERM = true;
    bf16* Q; const float* rp;
    __device__ __forceinline__ void operator()(const f32x4 (&acc)[2][2][4][2], const pg8::Unit& u, int wr, int wc, int fr, int fq) const {
        const int row0 = u.pm * 256 + wr * 64 + fr;
        if (u.pn < 2) {
#pragma unroll
            for (int ai = 0; ai < 2; ++ai)
#pragma unroll
                for (int m = 0; m < 4; ++m) { const int n = row0 + ai * 128 + m * 16;
#pragma unroll
                    for (int bj = 0; bj < 2; ++bj) { const f32x4 v0 = acc[ai][bj][m][0] * MLA_QS, v1 = acc[ai][bj][m][1] * MLA_QS;
                        u32x4 w; w.x = cvtpk(v0[0], v0[1]); w.y = cvtpk(v0[2], v0[3]); w.z = cvtpk(v1[0], v1[1]); w.w = cvtpk(v1[2], v1[3]);
                        *(u32x4*)(Q + (size_t)n * 768 + (2 * u.pn + bj) * 192 + wc * 32 + 8 * fq) = w; } }
        } else {
#pragma unroll
            for (int ai = 0; ai < 2; ++ai)
#pragma unroll
                for (int m = 0; m < 4; ++m) { const int n = row0 + ai * 128 + m * 16;
                    f32x4 a0 = acc[ai][0][m][0] * MLA_QS, a1 = acc[ai][0][m][1] * MLA_QS, b0 = acc[ai][1][m][0] * MLA_QS, b1 = acc[ai][1][m][1] * MLA_QS;
#ifdef PROBE_NOROPE
                    if (false) { const int rl = n & 255, prow = (u.pm & 31) * 4 + (rl >> 6), pcol = rl & 63;
#else
                    if (u.pm < 64) { const int rl = n & 255, prow = (u.pm & 31) * 4 + (rl >> 6), pcol = rl & 63;
#endif
                        const float* cp = (fq < 2) ? (rp + prow * 16 + 8 * fq) : (rp + 4096 + pcol * 16 + 8 * (fq - 2));
                        const float* sp = cp + ((fq < 2) ? 2048 : 1024);
                        const f32x4 c0 = *(const f32x4*)cp, c1 = *(const f32x4*)(cp + 4), s0 = *(const f32x4*)sp, s1 = *(const f32x4*)(sp + 4);
                        const f32x4 o0 = a0 * c0 - b0 * s0, o1 = a1 * c1 - b1 * s1, p0 = b0 * c0 + a0 * s0, p1 = b1 * c1 + a1 * s1;
                        a0 = o0; a1 = o1; b0 = p0; b1 = p1; }
                    u32x4 w; w.x = cvtpk(a0[0], a0[1]); w.y = cvtpk(a0[2], a0[3]); w.z = cvtpk(a1[0], a1[1]); w.w = cvtpk(a1[2], a1[3]);
                    bf16* dst = Q + (size_t)n * 768 + wc * 192 + 128 + 8 * fq;
                    *(u32x4*)dst = w;
                    w.x = cvtpk(b0[0], b0[1]); w.y = cvtpk(b0[2], b0[3]); w.z = cvtpk(b1[0], b1[1]); w.w = cvtpk(b1[2], b1[3]);
                    *(u32x4*)(dst + 32) = w; }
        }
    }
};
struct EpiKVmla {
    static constexpr bool PERM = true;
    bf16* Kd; bf16* Vd;
    __device__ __forceinline__ void operator()(const f32x4 (&acc)[2][2][4][2], const pg8::Unit& u, int wr, int wc, int fr, int fq) const {
        const int b = (u.pm < 64) ? (u.pm >> 5) : (u.pm - 64), pos0 = (u.pm < 64) ? (CTXL + (u.pm & 31) * 256) : 0;
        bf16* kb = Kd + ((size_t)(b * 4 + u.pn) * SKV + pos0) * 192 + wc * 32 + 8 * fq;
        bf16* vb = Vd + ((size_t)(b * 4 + u.pn) * SKV + pos0) * 128 + wc * 32 + 8 * fq;
        const int r0 = wr * 64 + fr;
#pragma unroll
        for (int ai = 0; ai < 2; ++ai)
#pragma unroll
            for (int m = 0; m < 4; ++m) { const int r = r0 + ai * 128 + m * 16;
                { const f32x4 v0 = acc[ai][0][m][0], v1 = acc[ai][0][m][1];
                  u32x4 w; w.x = cvtpk(v0[0], v0[1]); w.y = cvtpk(v0[2], v0[3]); w.z = cvtpk(v1[0], v1[1]); w.w = cvtpk(v1[2], v1[3]);
                  *(u32x4*)(kb + r * 192) = w; }
                { const f32x4 v0 = acc[ai][1][m][0], v1 = acc[ai][1][m][1];
                  u32x4 w; w.x = cvtpk(v0[0], v0[1]); w.y = cvtpk(v0[2], v0[3]); w.z = cvtpk(v1[0], v1[1]); w.w = cvtpk(v1[2], v1[3]);
                  *(u32x4*)(vb + r * 128) = w; } }
    }
};
struct EpiGLU {
    static constexpr bool PERM = true;
    bf16* H; const float* roww; const LAS int* cnt;
    __device__ __forceinline__ void operator()(const f32x4 (&acc)[2][2][4][2], const pg8::Unit& u, int wr, int wc, int fr, int fq) const {
        const int ne = u.ne;
        float cwv[2][4];
#pragma unroll
        for (int ai = 0; ai < 2; ++ai)
#pragma unroll
            for (int m = 0; m < 4; ++m) { const int pos = u.j * 256 + ai * 128 + wr * 64 + m * 16 + fr; cwv[ai][m] = (pos < ne) ? roww[(size_t)u.e * M + pos] : 0.f; }
#pragma unroll
        for (int ai = 0; ai < 2; ++ai)
#pragma unroll
            for (int m = 0; m < 4; ++m) { const int r = ai * 128 + wr * 64 + m * 16 + fr;
                const float cw = cwv[ai][m];
                f32x4 h0, h1;
#pragma unroll
                for (int q = 0; q < 4; ++q) { const float g0 = acc[ai][0][m][0][q], g1 = acc[ai][0][m][1][q];
                    h0[q] = siluf_(g0) * acc[ai][1][m][0][q] * cw; h1[q] = siluf_(g1) * acc[ai][1][m][1][q] * cw; }
                u32x4 w; w.x = cvtpk(h0[0], h0[1]); w.y = cvtpk(h0[2], h0[3]); w.z = cvtpk(h1[0], h1[1]); w.w = cvtpk(h1[2], h1[3]);
                *(u32x4*)(H + (size_t)(u.pm * 256 + r) * DEXP + u.pn * 128 + wc * 32 + 8 * fq) = w; }
    }
};
struct EpiGLUHalf {
    static constexpr bool PERM = true;
    bf16* H; const float* roww; const LAS int* cnt;
    __device__ __forceinline__ void operator()(const f32x4 (&acc)[2][2][4][2], const pg8::Unit& u, int wr, int wc, int fr, int fq) const {
        const int ne = u.ne;
        float cwv[4];
#pragma unroll
        for (int m = 0; m < 4; ++m) { const int pos = u.j * 256 + u.hf * 128 + wr * 64 + m * 16 + fr; cwv[m] = (pos < ne) ? roww[(size_t)u.e * M + pos] : 0.f; }
#pragma unroll
        for (int m = 0; m < 4; ++m) { const int r = u.hf * 128 + wr * 64 + m * 16 + fr;
            const float cw = cwv[m];
            f32x4 h0, h1;
#pragma unroll
            for (int q = 0; q < 4; ++q) { const float g0 = acc[0][0][m][0][q], g1 = acc[0][0][m][1][q];
                h0[q] = siluf_(g0) * acc[0][1][m][0][q] * cw; h1[q] = siluf_(g1) * acc[0][1][m][1][q] * cw; }
            u32x4 w; w.x = cvtpk(h0[0], h0[1]); w.y = cvtpk(h0[2], h0[3]); w.z = cvtpk(h1[0], h1[1]); w.w = cvtpk(h1[2], h1[3]);
            *(u32x4*)(H + (size_t)(u.pm * 256 + r) * DEXP + u.pn * 128 + wc * 32 + 8 * fq) = w; }
    }
};
struct MoeDeal {
    int G, c, ncol_shift; const LAS int* tp;
    __device__ __forceinline__ bool unit(int i, int& rt, int& pn) const {
        const int R = __builtin_amdgcn_readfirstlane(tp[16]), ncol = 1 << ncol_shift;
        if (G == 256) { const int x = c & 7, y = c >> 3, q = R >> 3, r = R & 7, base = x * q + (x < r ? x : r), cnt = q + (x < r ? 1 : 0);
            const int k = i * 32 + y; if (k >= cnt * ncol) return false; rt = base + (k >> ncol_shift); pn = k & (ncol - 1); return true; }
        const int L = i * G + c; if (L >= R * ncol) return false; rt = L >> ncol_shift; pn = L & (ncol - 1); return true;
    }
};
struct MoeOrder1 {
    static constexpr bool GATHER = true;
    int G, c; const LAS int* tp; const LAS int* cnt; const int* list; int maxr;
    __device__ bool next(int i, pg8::Unit& u) const {
        if (i >= maxr) return false;
        int rt, pn; const MoeDeal dl{G, c, 2, tp}; if (!dl.unit(i, rt, pn)) return false;
        int e = 0;
#pragma unroll
        for (int k = 1; k < 16; ++k) e += (rt >= __builtin_amdgcn_readfirstlane(tp[k])) ? 1 : 0;
        u.pm = rt; u.pn = pn; u.e = e; u.j = rt - __builtin_amdgcn_readfirstlane(tp[e]); u.ne = __builtin_amdgcn_readfirstlane(cnt[e]); u.hf = 0; return true;
    }
    __device__ __forceinline__ unsigned a_row(const pg8::Unit& u, int r) const { const int pos = u.j * 256 + r; return (pos < u.ne) ? (unsigned)list[(size_t)u.e * M + pos] : 0u; }
    __device__ __forceinline__ size_t b_off(const pg8::Unit& u) const { return ((size_t)u.e * 1024 + (size_t)u.pn * 256) * D * 2; }
};
struct MoeOrder1Tail {
    static constexpr bool GATHER = true;
    int G, c; const LAS int* tp; const LAS int* cnt; const int* list;
    __device__ bool next(int i, pg8::Unit& u) const {
        if (i > 0) return false;
        const int y = c >> 3; int rt, pn; const MoeDeal dl{G, (c & 7) | (((y >> 1) & 31) << 3), 2, tp}; if (!dl.unit(2, rt, pn)) return false;
        int e = 0;
#pragma unroll
        for (int k = 1; k < 16; ++k) e += (rt >= __builtin_amdgcn_readfirstlane(tp[k])) ? 1 : 0;
        u.pm = rt; u.pn = pn; u.e = e; u.j = rt - __builtin_amdgcn_readfirstlane(tp[e]); u.ne = __builtin_amdgcn_readfirstlane(cnt[e]); u.hf = y & 1; return true;
    }
    __device__ __forceinline__ unsigned a_row(const pg8::Unit& u, int r) const { const int pos = u.j * 256 + u.hf * 128 + (r & 127); return (pos < u.ne) ? (unsigned)list[(size_t)u.e * M + pos] : 0u; }
    __device__ __forceinline__ size_t b_off(const pg8::Unit& u) const { return ((size_t)u.e * 1024 + (size_t)u.pn * 256) * D * 2; }
};
struct MoeOrder2 {
    static constexpr bool GATHER = false;
    int G, c; const LAS int* tp; int maxr;
    __device__ bool next(int i, pg8::Unit& u) const {
        if (i >= maxr) return false;
        int rt, pn; const MoeDeal dl{G, c, 3, tp}; if (!dl.unit(i, rt, pn)) return false;
        int e = 0;
#pragma unroll
        for (int k = 1; k < 16; ++k) e += (rt >= __builtin_amdgcn_readfirstlane(tp[k])) ? 1 : 0;
        u.pm = rt; u.pn = pn; u.e = e; u.j = rt - __builtin_amdgcn_readfirstlane(tp[e]); u.ne = 0; u.hf = 0; return true;
    }
    __device__ __forceinline__ unsigned a_row(const pg8::Unit& u, int r) const { return (unsigned)(u.pm * 256 + r); }
    __device__ __forceinline__ size_t b_off(const pg8::Unit& u) const { return ((size_t)u.e * D + (size_t)u.pn * 256) * DEXP * 2; }
};
struct MoeOrder2Tail {
    static constexpr bool GATHER = false;
    int G, c; const LAS int* tp;
    __device__ bool next(int i, pg8::Unit& u) const {
        const int hh = i * 32 + (c >> 3), k = hh >> 1; if (k >= 32) return false;
        int rt, pn; const MoeDeal dl{G, (c & 7) | (k << 3), 3, tp}; if (!dl.unit(4, rt, pn)) return false;
        int e = 0;
#pragma unroll
        for (int q = 1; q < 16; ++q) e += (rt >= __builtin_amdgcn_readfirstlane(tp[q])) ? 1 : 0;
        u.pm = rt; u.pn = pn; u.e = e; u.j = rt - __builtin_amdgcn_readfirstlane(tp[e]); u.ne = 0; u.hf = hh & 1; return true;
    }
    __device__ __forceinline__ unsigned a_row(const pg8::Unit& u, int r) const { return (unsigned)(u.pm * 256 + u.hf * 128 + (r & 127)); }
    __device__ __forceinline__ size_t b_off(const pg8::Unit& u) const { return ((size_t)u.e * D + (size_t)u.pn * 256) * DEXP * 2; }
};

namespace att {
constexpr int NW = 8, QBLK = 32, KVBLK = 64;
constexpr float THR = 8.f;
constexpr int SHM_V = KVBLK * 128 * 2, SHM_K = KVBLK * 128 * 2, SHM_KR = KVBLK * 64 * 2;
constexpr int OFF_V = 0, OFF_K = 2 * SHM_V, OFF_WS = OFF_K + 2 * SHM_K, OFF_KR = OFF_WS + NW * 64 * 4, OFF_QR = OFF_KR + 2 * SHM_KR, LDS_END = OFF_QR + 256 * 128;
static_assert(LDS_END <= LDS_MISC, "attention LDS");
#define KSWZ(row, colB) ((row) * 256 + ((colB) ^ (((row) & 7) << 4)))
#define RSWZ(row, ch) ((row) * 128 + ((((ch) ^ ((row) >> 1)) & 7) << 4))
__device__ __forceinline__ int crow(int r, int hi) { return (r & 3) + 8 * (r >> 2) + 4 * hi; }

template <int DQK, int MODE>
__device__ __forceinline__ void partialSM(f32x16& p0, f32x16& p1, float& m_reg, float& mn, float& alpha) {
    if constexpr (MODE == 2) {
        alpha = 1.f; mn = 0.f;
#pragma unroll
        for (int r = 0; r < 16; ++r) p0[r] = __builtin_amdgcn_exp2f(p0[r]);
        return;
    }
    constexpr float SCALE = (MODE == 1) ? 0.6931471805599453f : ((DQK == 128) ? 0.088388347648318440f : 0.072168783648703220f);
    constexpr float C = SCALE * 1.4426950408889634f;
    float pmax = p0[0];
#pragma unroll
    for (int r = 1; r < 16; ++r) pmax = fmaxf(pmax, p0[r]);
#pragma unroll
    for (int r = 0; r < 16; ++r) pmax = fmaxf(pmax, p1[r]);
    { auto rr = __builtin_amdgcn_permlane32_swap(__float_as_uint(pmax), __float_as_uint(pmax), false, false);
      pmax = fmaxf(__uint_as_float(rr[0]), __uint_as_float(rr[1])); }
    if (__builtin_expect(__all(pmax - m_reg <= THR / SCALE), 1)) { mn = m_reg; alpha = 1.f; }
    else { mn = fmaxf(m_reg, pmax); alpha = __builtin_amdgcn_exp2f((m_reg - mn) * C); m_reg = mn; }
    const float mnC = -mn * C;
#pragma unroll
    for (int r = 0; r < 16; ++r) p0[r] = fmaf(p0[r], C, mnC);
#pragma unroll
    for (int r = 0; r < 16; ++r) p1[r] = fmaf(p1[r], C, mnC);
#pragma unroll
    for (int r = 0; r < 16; ++r) p0[r] = __builtin_amdgcn_exp2f(p0[r]);
}
__device__ __forceinline__ void finishSM_a(f32x16& p1) {
#pragma unroll
    for (int r = 0; r < 16; ++r) p1[r] = __builtin_amdgcn_exp2f(p1[r]);
}
template <bool EXPDONE = false>
__device__ __forceinline__ void finishSM(f32x16& p0, f32x16& p1, float alpha, float& l_reg, bf16x8& pa0, bf16x8& pa1, bf16x8& pa2, bf16x8& pa3) {
    if constexpr (!EXPDONE) {
#pragma unroll
    for (int r = 0; r < 16; ++r) p1[r] = __builtin_amdgcn_exp2f(p1[r]);
    }
    float ps = 0;
#pragma unroll
    for (int r = 0; r < 16; ++r) ps += p0[r];
#pragma unroll
    for (int r = 0; r < 16; ++r) ps += p1[r];
    { auto rr = __builtin_amdgcn_permlane32_swap(__float_as_uint(ps), __float_as_uint(ps), false, false);
      ps = __uint_as_float(rr[0]) + __uint_as_float(rr[1]); }
    l_reg = l_reg * alpha + ps;
#define PK4(P, BASE, OUT) do { unsigned a0 = cvtpk(P[BASE + 0], P[BASE + 1]), a1 = cvtpk(P[BASE + 2], P[BASE + 3]);   \
    unsigned b0 = cvtpk(P[BASE + 4], P[BASE + 5]), b1 = cvtpk(P[BASE + 6], P[BASE + 7]);                              \
    auto r0 = __builtin_amdgcn_permlane32_swap(a0, b0, false, false); auto r1 = __builtin_amdgcn_permlane32_swap(a1, b1, false, false); \
    u32x4 w = {r0[0], r1[0], r0[1], r1[1]}; OUT = *reinterpret_cast<bf16x8*>(&w); } while (0)
    PK4(p0, 0, pa0); PK4(p0, 8, pa1); PK4(p1, 0, pa2); PK4(p1, 8, pa3);
#undef PK4
}
template <int DQK, int KPF = 0>
__device__ __forceinline__ void qkt(f32x16& p0, f32x16& p1, const char* Ks, const char* KRs, const char* QRs, const bf16x8* qr, int r32, int hi, int qrow) {
    p0 = f32x16{}; p1 = f32x16{};
    if constexpr ((KPF & 1) != 0) {
#define QK_RD(d0_, B0_, B1_) do { const int cb_ = ((d0_) * 16 + hi * 8) * 2; B0_ = *reinterpret_cast<const bf16x8*>(Ks + KSWZ(r32, cb_)); B1_ = *reinterpret_cast<const bf16x8*>(Ks + KSWZ(32 + r32, cb_)); } while (0)
        bf16x8 a0, a1, c0, c1;
        QK_RD(0, a0, a1);
#pragma unroll
        for (int d0 = 0; d0 < 8; d0 += 2) {
            QK_RD(d0 + 1, c0, c1); SBAR();
            p0 = __builtin_amdgcn_mfma_f32_32x32x16_bf16(a0, qr[d0], p0, 0, 0, 0); p1 = __builtin_amdgcn_mfma_f32_32x32x16_bf16(a1, qr[d0], p1, 0, 0, 0); SBAR();
            if (d0 + 2 < 8) { QK_RD(d0 + 2, a0, a1); } SBAR();
            p0 = __builtin_amdgcn_mfma_f32_32x32x16_bf16(c0, qr[d0 + 1], p0, 0, 0, 0); p1 = __builtin_amdgcn_mfma_f32_32x32x16_bf16(c1, qr[d0 + 1], p1, 0, 0, 0); SBAR();
        }
#undef QK_RD
    } else {
#pragma unroll
    for (int d0 = 0; d0 < 8; ++d0) { const int cb = (d0 * 16 + hi * 8) * 2;
        bf16x8 b0 = *reinterpret_cast<const bf16x8*>(Ks + KSWZ(r32, cb));
        bf16x8 b1 = *reinterpret_cast<const bf16x8*>(Ks + KSWZ(32 + r32, cb));
        p0 = __builtin_amdgcn_mfma_f32_32x32x16_bf16(b0, qr[d0], p0, 0, 0, 0);
        p1 = __builtin_amdgcn_mfma_f32_32x32x16_bf16(b1, qr[d0], p1, 0, 0, 0); }
    }
    if constexpr (DQK == 192) {
        SBAR();
#pragma unroll
        for (int d0 = 0; d0 < 4; ++d0) { const int ch = d0 * 2 + hi;
            bf16x8 b0 = *reinterpret_cast<const bf16x8*>(KRs + RSWZ(r32, ch));
            bf16x8 b1 = *reinterpret_cast<const bf16x8*>(KRs + RSWZ(32 + r32, ch));
            bf16x8 q = *reinterpret_cast<const bf16x8*>(QRs + RSWZ(qrow, ch));
            p0 = __builtin_amdgcn_mfma_f32_32x32x16_bf16(b0, q, p0, 0, 0, 0);
            p1 = __builtin_amdgcn_mfma_f32_32x32x16_bf16(b1, q, p1, 0, 0, 0); }
    }
}
#define QK_RD2(d0_, B0_, B1_) do { const int cb_ = ((d0_) * 16 + hi * 8) * 2; B0_ = *reinterpret_cast<const bf16x8*>(Ks + KSWZ(r32, cb_)); B1_ = *reinterpret_cast<const bf16x8*>(Ks + KSWZ(32 + r32, cb_)); } while (0)
__device__ __forceinline__ void qk_pre(const char* Ks, int r32, int hi, bf16x8& a0, bf16x8& a1, bf16x8& c0, bf16x8& c1) { QK_RD2(0, a0, a1); QK_RD2(1, c0, c1); SBAR(); }
__device__ __forceinline__ void qk_main(f32x16& p0, f32x16& p1, const char* Ks, const bf16x8* qr, int r32, int hi, bf16x8 a0, bf16x8 a1, bf16x8 c0, bf16x8 c1) {
    p0 = f32x16{}; p1 = f32x16{};
#pragma unroll
    for (int d0 = 0; d0 < 8; d0 += 2) {
        if (d0 > 0) { QK_RD2(d0 + 1, c0, c1); } SBAR();
        p0 = __builtin_amdgcn_mfma_f32_32x32x16_bf16(a0, qr[d0], p0, 0, 0, 0); p1 = __builtin_amdgcn_mfma_f32_32x32x16_bf16(a1, qr[d0], p1, 0, 0, 0); SBAR();
        if (d0 + 2 < 8) { QK_RD2(d0 + 2, a0, a1); } SBAR();
        p0 = __builtin_amdgcn_mfma_f32_32x32x16_bf16(c0, qr[d0 + 1], p0, 0, 0, 0); p1 = __builtin_amdgcn_mfma_f32_32x32x16_bf16(c1, qr[d0 + 1], p1, 0, 0, 0); SBAR();
    }
}
#undef QK_RD2
__device__ __forceinline__ int v_st(int k, int c) { const int kk = (k & ~0xC) | ((k & 4) << 1) | ((k & 8) >> 1); return ((kk >> 3) * 4 + (c >> 5)) * 512 + ((kk & 7) * 32 + (c & 31)) * 2; }
__device__ __forceinline__ int v_rd_base(int lane) { return ((lane & 3) << 3) | (((lane >> 2) & 3) << 6) | (((lane >> 4) & 1) << 5) | (((lane >> 5) & 1) << 8); }
constexpr int v_rd_off(int d0, int ks, int half) { return d0 * 512 + ks * 4096 + half * 2048; }
template <int OFF> __device__ __forceinline__ s16x4 tr_read(int vb) {
    s16x4 r; asm volatile("ds_read_b64_tr_b16 %0, %1 offset:%2" : "=&v"(r) : "v"(vb), "i"(OFF) : "memory"); return r;
}
template <int D0> __device__ __forceinline__ void pv_one(f32x16& od, int vb, bf16x8 pa0, bf16x8 pa1, bf16x8 pa2, bf16x8 pa3) {
    const s16x4 l0 = tr_read<v_rd_off(D0, 0, 0)>(vb), h0 = tr_read<v_rd_off(D0, 0, 1)>(vb), l1 = tr_read<v_rd_off(D0, 1, 0)>(vb), h1 = tr_read<v_rd_off(D0, 1, 1)>(vb);
    const s16x4 l2 = tr_read<v_rd_off(D0, 2, 0)>(vb), h2 = tr_read<v_rd_off(D0, 2, 1)>(vb), l3 = tr_read<v_rd_off(D0, 3, 0)>(vb), h3 = tr_read<v_rd_off(D0, 3, 1)>(vb);
    asm volatile("s_waitcnt lgkmcnt(0)" ::: "memory"); SBAR();
#define PK(L, H) (bf16x8){L[0], L[1], L[2], L[3], H[0], H[1], H[2], H[3]}
    od = __builtin_amdgcn_mfma_f32_32x32x16_bf16(pa0, PK(l0, h0), od, 0, 0, 0);
    od = __builtin_amdgcn_mfma_f32_32x32x16_bf16(pa1, PK(l1, h1), od, 0, 0, 0);
    od = __builtin_amdgcn_mfma_f32_32x32x16_bf16(pa2, PK(l2, h2), od, 0, 0, 0);
    od = __builtin_amdgcn_mfma_f32_32x32x16_bf16(pa3, PK(l3, h3), od, 0, 0, 0);
#undef PK
}
__device__ __forceinline__ void pv_d0(f32x16* o, int vb, bf16x8 pa0, bf16x8 pa1, bf16x8 pa2, bf16x8 pa3) {
    pv_one<0>(o[0], vb, pa0, pa1, pa2, pa3); pv_one<1>(o[1], vb, pa0, pa1, pa2, pa3); pv_one<2>(o[2], vb, pa0, pa1, pa2, pa3); pv_one<3>(o[3], vb, pa0, pa1, pa2, pa3);
}
struct VPre { s16x4 l0, h0, l1, h1, l2, h2, l3, h3; };
__device__ __forceinline__ void pv_prefetch(VPre& f, int vb) {
    f.l0 = tr_read<v_rd_off(0, 0, 0)>(vb); f.h0 = tr_read<v_rd_off(0, 0, 1)>(vb); f.l1 = tr_read<v_rd_off(0, 1, 0)>(vb); f.h1 = tr_read<v_rd_off(0, 1, 1)>(vb);
    f.l2 = tr_read<v_rd_off(0, 2, 0)>(vb); f.h2 = tr_read<v_rd_off(0, 2, 1)>(vb); f.l3 = tr_read<v_rd_off(0, 3, 0)>(vb); f.h3 = tr_read<v_rd_off(0, 3, 1)>(vb); SBAR();
}
__device__ __forceinline__ void pv_d0_pre(f32x16* o, int vb, const VPre& f, bf16x8 pa0, bf16x8 pa1, bf16x8 pa2, bf16x8 pa3) {
    asm volatile("s_waitcnt lgkmcnt(0)" ::: "memory"); SBAR();
#define PK(L, H) (bf16x8){L[0], L[1], L[2], L[3], H[0], H[1], H[2], H[3]}
    o[0] = __builtin_amdgcn_mfma_f32_32x32x16_bf16(pa0, PK(f.l0, f.h0), o[0], 0, 0, 0);
    o[0] = __builtin_amdgcn_mfma_f32_32x32x16_bf16(pa1, PK(f.l1, f.h1), o[0], 0, 0, 0);
    o[0] = __builtin_amdgcn_mfma_f32_32x32x16_bf16(pa2, PK(f.l2, f.h2), o[0], 0, 0, 0);
    o[0] = __builtin_amdgcn_mfma_f32_32x32x16_bf16(pa3, PK(f.l3, f.h3), o[0], 0, 0, 0);
#undef PK
    pv_one<1>(o[1], vb, pa0, pa1, pa2, pa3); pv_one<2>(o[2], vb, pa0, pa1, pa2, pa3); pv_one<3>(o[3], vb, pa0, pa1, pa2, pa3);
}
template <int DQK, int LDQ, int LDK, int LDO, int SD, int MODE, int KPF = 0>
__device__ __forceinline__ bool attn_body(const bf16* __restrict__ Qb, const bf16* __restrict__ Kh, const bf16* __restrict__ Vh, bf16* __restrict__ Ob, int seq, char* lds) {
    const int tid = opaque_tid(), wid = tid >> 6, lane = tid & 63, r32 = lane & 31, hi = lane >> 5;
    char* V_lds = lds + OFF_V; char* K_lds = lds + OFF_K; char* KR_lds = lds + OFF_KR; char* QR_lds = lds + OFF_QR;
    float* ws = (float*)(lds + OFF_WS) + wid * 64; float* li_l = ws; float* al_l = ws + 32;
    float m_reg = -1e30f, l_reg = 0; f32x16 o[4] = {}; bf16x8 qr[8];
    const int qrow = wid * QBLK + r32;
    const bf16* Qw = Qb + (long)qrow * LDQ + hi * 8;
#pragma unroll
    for (int d0 = 0; d0 < 8; ++d0) { qr[d0] = *reinterpret_cast<const bf16x8*>(Qw + d0 * 16);
#ifdef PROBE_QZERO
        qr[d0] = (bf16x8){0, 0, 0, 0, 0, 0, 0, 0};
#endif
    }
    if constexpr (DQK == 192) {
#pragma unroll
        for (int d0 = 0; d0 < 4; ++d0) { bf16x8 q = *reinterpret_cast<const bf16x8*>(Qw + 128 + d0 * 16);
#ifdef PROBE_QZERO
            q = (bf16x8){0, 0, 0, 0, 0, 0, 0, 0};
#endif
            *reinterpret_cast<bf16x8*>(QR_lds + RSWZ(qrow, d0 * 2 + hi)) = q; }
    }
    const int sr = tid >> 4, sc = (tid & 15) * 8, vst0 = v_st(sr, sc), vst1 = v_st(32 + sr, sc);
    const int rr_ = tid >> 3, rc_ = tid & 7;
    const int vb0 = (int)(uintptr_t)V_lds + v_rd_base(lane);
    bf16x8 sv0[SD], sv1[SD], sk0[SD], sk1[SD], skr[SD];
#define SLOAD(i, k0) do { sv0[i] = *reinterpret_cast<const bf16x8*>(&Vh[(long)((k0) + sr) * 128 + sc]); sv1[i] = *reinterpret_cast<const bf16x8*>(&Vh[(long)((k0) + 32 + sr) * 128 + sc]); \
    sk0[i] = *reinterpret_cast<const bf16x8*>(&Kh[(long)((k0) + sr) * LDK + sc]); sk1[i] = *reinterpret_cast<const bf16x8*>(&Kh[(long)((k0) + 32 + sr) * LDK + sc]); \
    if constexpr (DQK == 192) skr[i] = *reinterpret_cast<const bf16x8*>(&Kh[(long)((k0) + rr_) * LDK + 128 + rc_ * 8]); } while (0)
#define SWRITE(b, i) do { *(bf16x8*)(V_lds + (b) * SHM_V + vst0) = sv0[i]; *(bf16x8*)(V_lds + (b) * SHM_V + vst1) = sv1[i]; const int kc = sc * 2; \
    *(bf16x8*)(K_lds + (b) * SHM_K + KSWZ(sr, kc)) = sk0[i]; *(bf16x8*)(K_lds + (b) * SHM_K + KSWZ(32 + sr, kc)) = sk1[i]; \
    if constexpr (DQK == 192) *(bf16x8*)(KR_lds + (b) * SHM_KR + RSWZ(rr_, rc_)) = skr[i]; } while (0)
#define SWAIT() do { if constexpr (SD == 1) asm volatile("s_waitcnt vmcnt(0)" ::: "memory"); else if constexpr (DQK == 192) asm volatile("s_waitcnt vmcnt(5)" ::: "memory"); else asm volatile("s_waitcnt vmcnt(4)" ::: "memory"); } while (0)
#define RESC(a) do { if (MODE != 2 && __any((a) < 1.f)) { if (hi == 0) al_l[r32] = (a); asm volatile("s_waitcnt lgkmcnt(0)" ::: "memory"); \
    _Pragma("unroll") for (int d = 0; d < 4; ++d) _Pragma("unroll") for (int r = 0; r < 16; ++r) o[d][r] *= al_l[crow(r, hi)]; } } while (0)
    f32x16 pA0, pA1, pB0, pB1; float mnA, mnB, alA, alB; bf16x8 pa0, pa1, pa2, pa3; const int NT = seq / KVBLK;
    constexpr int SE = 0, SO = SD - 1;
    SLOAD(SE, 0); asm volatile("s_waitcnt vmcnt(0)" ::: "memory"); SWRITE(0, SE); __syncthreads();
    qkt<DQK, KPF>(pA0, pA1, K_lds, KR_lds, QR_lds, qr, r32, hi, qrow); partialSM<DQK, MODE>(pA0, pA1, m_reg, mnA, alA);
    SLOAD(SO, KVBLK); if constexpr (SD == 2) { if (2 < NT) SLOAD(SE, 2 * KVBLK); }
    SWAIT(); SWRITE(1, SO); __syncthreads();
    if constexpr ((KPF & 4) != 0) {
      if (__builtin_amdgcn_readfirstlane(wid) >= 4) __builtin_amdgcn_s_setprio(1);
      for (int j = 1; j + 1 < NT; j += 2) {
        bf16x8 ka0, ka1, kc0, kc1; VPre vf;
        SBAR(); qk_pre(K_lds + SHM_K, r32, hi, ka0, ka1, kc0, kc1);
        finishSM_a(pA1); SBAR();
        qk_main(pB0, pB1, K_lds + SHM_K, qr, r32, hi, ka0, ka1, kc0, kc1);
        pv_prefetch(vf, vb0);
        finishSM<true>(pA0, pA1, alA, l_reg, pa0, pa1, pa2, pa3); SBAR();
        SLOAD(SO, (j + SD) * KVBLK); SBAR();
        pv_d0_pre(o, vb0, vf, pa0, pa1, pa2, pa3);
        partialSM<DQK, MODE>(pB0, pB1, m_reg, mnB, alB);
        __syncthreads(); SWAIT(); SWRITE(0, SE);
        RESC(alB); __syncthreads();
        SBAR(); qk_pre(K_lds, r32, hi, ka0, ka1, kc0, kc1);
        finishSM_a(pB1); SBAR();
        qk_main(pA0, pA1, K_lds, qr, r32, hi, ka0, ka1, kc0, kc1);
        pv_prefetch(vf, vb0 + (int)SHM_V);
        finishSM<true>(pB0, pB1, alB, l_reg, pa0, pa1, pa2, pa3); SBAR();
        if (SD == 1 || j + 3 < NT) SLOAD(SE, (j + 1 + SD) * KVBLK); SBAR();
        pv_d0_pre(o, vb0 + (int)SHM_V, vf, pa0, pa1, pa2, pa3);
        partialSM<DQK, MODE>(pA0, pA1, m_reg, mnA, alA);
        __syncthreads(); SWAIT(); SWRITE(1, SO);
        RESC(alA); __syncthreads();
      }
    } else
    for (int j = 1; j + 1 < NT; j += 2) {
        SBAR(); qkt<DQK, KPF>(pB0, pB1, K_lds + SHM_K, KR_lds + SHM_KR, QR_lds, qr, r32, hi, qrow);
        VPre vf; if constexpr ((KPF & 2) != 0) pv_prefetch(vf, vb0);
        finishSM(pA0, pA1, alA, l_reg, pa0, pa1, pa2, pa3); SBAR();
        SLOAD(SO, (j + SD) * KVBLK); SBAR();
        if constexpr ((KPF & 2) != 0) pv_d0_pre(o, vb0, vf, pa0, pa1, pa2, pa3); else pv_d0(o, vb0, pa0, pa1, pa2, pa3);
        partialSM<DQK, MODE>(pB0, pB1, m_reg, mnB, alB);
        __syncthreads(); SWAIT(); SWRITE(0, SE);
        RESC(alB); __syncthreads();
        SBAR(); qkt<DQK, KPF>(pA0, pA1, K_lds, KR_lds, QR_lds, qr, r32, hi, qrow);
        if constexpr ((KPF & 2) != 0) pv_prefetch(vf, vb0 + (int)SHM_V);
        finishSM(pB0, pB1, alB, l_reg, pa0, pa1, pa2, pa3); SBAR();
        if (SD == 1 || j + 3 < NT) SLOAD(SE, (j + 1 + SD) * KVBLK); SBAR();
        if constexpr ((KPF & 2) != 0) pv_d0_pre(o, vb0 + (int)SHM_V, vf, pa0, pa1, pa2, pa3); else pv_d0(o, vb0 + (int)SHM_V, pa0, pa1, pa2, pa3);
        partialSM<DQK, MODE>(pA0, pA1, m_reg, mnA, alA);
        __syncthreads(); SWAIT(); SWRITE(1, SO);
        RESC(alA); __syncthreads();
    }
    if constexpr ((KPF & 4) != 0) __builtin_amdgcn_s_setprio(0);
    SBAR(); qkt<DQK, KPF>(pB0, pB1, K_lds + SHM_K, KR_lds + SHM_KR, QR_lds, qr, r32, hi, qrow);
    finishSM(pA0, pA1, alA, l_reg, pa0, pa1, pa2, pa3); SBAR();
    pv_d0(o, vb0, pa0, pa1, pa2, pa3); partialSM<DQK, MODE>(pB0, pB1, m_reg, mnB, alB);
    __syncthreads(); RESC(alB);
    finishSM(pB0, pB1, alB, l_reg, pa0, pa1, pa2, pa3); SBAR();
    pv_d0(o, vb0 + (int)SHM_V, pa0, pa1, pa2, pa3);
    volatile int* badflag = (volatile int*)(lds + LDS_MISC + 200);
    if (MODE == 2) { const bool bad = !(l_reg > 0.f && l_reg < 1e30f); if (__any(bad) && lane == 0) *badflag = 1; }
    if (hi == 0) li_l[r32] = l_reg; asm volatile("s_waitcnt lgkmcnt(0)" ::: "memory");
    float rli[16];
#pragma unroll
    for (int r = 0; r < 16; ++r) rli[r] = __builtin_amdgcn_rcpf(li_l[crow(r, hi)]);
    bf16* Ow = Ob + (long)(wid * QBLK) * LDO;
#pragma unroll
    for (int r = 0; r < 16; ++r) { const int orow = crow(r, hi);
#pragma unroll
        for (int d0 = 0; d0 < 4; ++d0) Ow[(long)orow * LDO + d0 * 32 + r32] = f2bf(o[d0][r] * rli[r]); }
    __syncthreads();
    bool ok = true;
    if (MODE == 2) { ok = (*badflag == 0); __syncthreads(); if (tid == 0) *badflag = 0; }
#undef SLOAD
#undef SWRITE
#undef SWAIT
#undef RESC
    return ok;
}

}

struct Ctx {
    float* out; unsigned char* ws;
    int G, blk;
};
#define PHASE_IDS() const int tid = opaque_tid(); const int lane = tid & 63; const int wave = __builtin_amdgcn_readfirstlane(tid >> 6); (void)lane; (void)wave
__device__ __forceinline__ const float* cin(int i) {
    const __attribute__((address_space(4))) char* kp = (const __attribute__((address_space(4))) char*)__builtin_amdgcn_kernarg_segment_ptr();
    asm volatile("" : "+s"(kp));
    return *(const float* const __attribute__((address_space(4)))*)(kp + 8 * i);
}
#define CIN(i) cin(i)
#define IN_X 0
#define IN_C 1
#define IN_CTX 2
#define IN_CCTX 3
#define IN_WMOD 4
#define IN_BMOD 5
#define IN_WIN 6
#define IN_CONVW 7
#define IN_CONVB 8
#define IN_GATEB 9
#define IN_ANORM 10
#define IN_BQN 11
#define IN_BKN 12
#define IN_CQN 13
#define IN_WUQ 14
#define IN_CKVN 15
#define IN_WUKV 16
#define IN_WOUT 17
#define IN_LN1G 18
#define IN_LN1B 19
#define IN_LN2G 20
#define IN_LN2B 21
#define IN_WRG 22
#define IN_BRG 23
#define IN_WRE 24
#define IN_BRE 25
#define IN_EGATE 26
#define IN_EUP 27
#define IN_EDOWN 28
#define WSP(T_, off) ((T_*)(C.ws + (off)))

__device__ __forceinline__ void unpack8(const u32x4 w, float (&f)[8]) { f[0] = bflo(w.x); f[1] = bfhi(w.x); f[2] = bflo(w.y); f[3] = bfhi(w.y); f[4] = bflo(w.z); f[5] = bfhi(w.z); f[6] = bflo(w.w); f[7] = bfhi(w.w); }
__device__ __forceinline__ u32x4 pack8(const float (&f)[8]) { u32x4 w; w.x = cvtpk(f[0], f[1]); w.y = cvtpk(f[2], f[3]); w.z = cvtpk(f[4], f[5]); w.w = cvtpk(f[6], f[7]); return w; }
template <class RM>
__device__ __forceinline__ void transpose_item(const float* __restrict__ W, int K, int N, bf16* __restrict__ WT, float* scr, int item, int lane, RM rowmap) {
    const int nblk = (N + 31) >> 5, kb = item / nblk, nb = item - kb * nblk, k0 = 64 * kb, n0 = 32 * nb;
    const int c4 = (lane & 7) * 4, r8 = lane >> 3; const bool ok = n0 + c4 < N;
    f32x4 v[8];
#pragma unroll
    for (int i = 0; i < 8; ++i) v[i] = ok ? *(const f32x4*)(W + (size_t)(k0 + r8 + 8 * i) * N + n0 + c4) : (f32x4){0.f, 0.f, 0.f, 0.f};
#pragma unroll
    for (int i = 0; i < 8; ++i) { float* d = scr + (r8 + 8 * i) * 33 + c4; d[0] = v[i][0]; d[1] = v[i][1]; d[2] = v[i][2]; d[3] = v[i][3]; }
    LDS_WAIT(); asm volatile("" ::: "memory");
    const int c = lane & 7;
#pragma unroll
    for (int j = 0; j < 4; ++j) { const int n = (lane >> 3) + 8 * j;
        if (n0 + n < N) { const float* s = scr + (8 * c) * 33 + n;
            u32x4 o; o.x = cvtpk(s[0 * 33], s[1 * 33]); o.y = cvtpk(s[2 * 33], s[3 * 33]); o.z = cvtpk(s[4 * 33], s[5 * 33]); o.w = cvtpk(s[6 * 33], s[7 * 33]);
            *(u32x4*)(WT + (size_t)rowmap(n0 + n) * K + k0 + 8 * c) = o; } }
    LDS_WAIT(); asm volatile("" ::: "memory");
}
struct RmId { __device__ int operator()(int c) const { return c; } };
struct RmWin { __device__ int operator()(int c) const {
    if (c < 512) return ZMQ + c; if (c < 1024) return ZMV + (c - 512); if (c < 1040) return ZGATE + (c - 1024); if (c < 1552) return ZOG + (c - 1040);
    if (c < 3088) return c - 1552; return ZCQ + (c - 3088); } };
struct RmUq { __device__ int operator()(int c) const { const int h = c / 192, r = c - h * 192;
    if (r < 128) return (h >> 1) * 256 + (h & 1) * 128 + r; const int rr = r - 128; return (rr < 32) ? (512 + 32 * h + rr) : (640 + 32 * h + (rr - 32)); } };
struct RmGate { int add; __device__ int operator()(int c) const { return ((c >> 7) << 8) + (c & 127) + add; } };

static_assert((size_t)NEXP * 1024 * D * 2 + (size_t)NEXP * D * DEXP * 2 <= (size_t)NL * D * 4, "layer-1 expert weights fit d_out");
__device__ __forceinline__ bf16* wgu_base(const Ctx& C, int l) { (void)l; return WSP(bf16, WS_WGU); }
__device__ __forceinline__ bf16* wd_base(const Ctx& C, int l) { (void)l; return WSP(bf16, WS_WD); }
__device__ __forceinline__ void expert_item(const Ctx& C, int l, int it, float* scr, int lane) {
    const int e = it / 1536, r = it - e * 1536;
    bf16* wgu = wgu_base(C, l) + (size_t)e * 1024 * D; bf16* wd = wd_base(C, l) + (size_t)e * D * DEXP;
    const size_t eo = ((size_t)l * NEXP + e) * (size_t)D * DEXP;
    if (r < 512) transpose_item(CIN(IN_EGATE) + eo, D, DEXP, wgu, scr, r, lane, RmGate{0});
    else if (r < 1024) transpose_item(CIN(IN_EUP) + eo, D, DEXP, wgu, scr, r - 512, lane, RmGate{128});
    else transpose_item(CIN(IN_EDOWN) + eo, DEXP, D, wd, scr, r - 1024, lane, RmId{});
}
constexpr int IT_EXP = NEXP * 1536;
__device__ __forceinline__ void fill_finish(const Ctx& C, char* lds, int l, int b0, int nb) {
    PHASE_IDS(); float* scr = (float*)lds + wave * (64 * 33);
    for (int it = (C.blk - b0) * NWAVES + wave; it < IT_EXP; it += nb * NWAVES) expert_item(C, l, it, scr, lane);
}
constexpr int IT_WIN = 32 * 123, IT_WOUT = 32 * 64, IT_UQ = 8 * 24, IT_UKV = 4 * 32, IT_LAYER = IT_WIN + IT_WOUT + IT_UQ + IT_UKV;

__device__ __forceinline__ void phase_pre0(const Ctx& C, char* lds) {
    PHASE_IDS();
    float* sc = (float*)lds;
    float* part = sc + 3 * 2048;
    for (int item = C.blk; item < 192; item += C.G) {
        const int l = item / 96, j0 = (item % 96) * 128;
        for (int i = tid; i < 3 * 2048; i += NTHREADS) { const int s = i >> 11, k = i & 2047; const float v = (s < 2) ? CIN(IN_C)[s * 2048 + k] : CIN(IN_CCTX)[k]; sc[i] = v / (1.f + __expf(-v)); }
        __syncthreads();
        const int ks = tid >> 5, cq = tid & 31;
        const float* wp = CIN(IN_WMOD) + (size_t)l * D * 12288 + (size_t)(ks * 128) * 12288 + j0 + cq * 4;
        f32x4 a0 = {0, 0, 0, 0}, a1 = a0, a2 = a0;
        f32x4 wa[8], wb[8];
#define MOD_LOAD(W_, k0_) do { const float* q_ = wp + (size_t)(k0_) * 12288; _Pragma("unroll") for (int i_ = 0; i_ < 8; ++i_) W_[i_] = *(const f32x4*)(q_ + (size_t)i_ * 12288); } while (0)
#define MOD_FMA(W_, k0_) do { _Pragma("unroll") for (int i_ = 0; i_ < 8; ++i_) { const int k_ = ks * 128 + (k0_) + i_; a0 += W_[i_] * sc[k_]; a1 += W_[i_] * sc[2048 + k_]; a2 += W_[i_] * sc[4096 + k_]; } } while (0)
        MOD_LOAD(wa, 0);
#pragma nounroll
        for (int kb = 0; kb < 128; kb += 16) {
            MOD_LOAD(wb, kb + 8); SBAR();
            MOD_FMA(wa, kb); SBAR();
            const int kn = (kb + 16 < 128) ? kb + 16 : 0;
            MOD_LOAD(wa, kn); SBAR();
            MOD_FMA(wb, kb + 8); SBAR();
        }
#undef MOD_LOAD
#undef MOD_FMA
        *(f32x4*)(part + (ks * 3 + 0) * 128 + cq * 4) = a0; *(f32x4*)(part + (ks * 3 + 1) * 128 + cq * 4) = a1; *(f32x4*)(part + (ks * 3 + 2) * 128 + cq * 4) = a2;
        __syncthreads();
        if (tid < 384) { const int s = tid >> 7, j = tid & 127; float a = CIN(IN_BMOD)[l * 12288 + j0 + j];
#pragma unroll
            for (int q = 0; q < 16; ++q) a += part[(q * 3 + s) * 128 + j];
            WSP(float, WS_MOD)[(size_t)(l * 3 + s) * 12288 + j0 + j] = a; }
        __syncthreads();
    }
    { float* rp = WSP(float, WS_ROPE);
      for (int g = C.blk * NTHREADS + tid; g < 9216; g += C.G * NTHREADS) {
          int nf, p, f; float* base;
          if (g < 6144) { nf = 32; p = g >> 5; f = g & 31; base = rp; } else { nf = 16; const int q = g - 6144; p = q >> 4; f = q & 15; base = rp + 12288; }
          const float inv = powf(10000.f, -(float)f / (float)nf);
          const int pos = p < 128 ? p : p - 128; const float ang = (float)pos * inv;
          float* ct = (p < 128) ? (base + p * nf + f) : (base + 2 * 128 * nf + (p - 128) * nf + f);
          float* st = ct + ((p < 128) ? 128 * nf : 64 * nf);
          *ct = cosf(ang); *st = sinf(ang); } }
    { bf16* w = WSP(bf16, WS_WIN);
      const int nz = 2 * (ZW - INW) * (D / 8);
      for (int g = C.blk * NTHREADS + tid; g < nz; g += C.G * NTHREADS) { const int l = g / ((ZW - INW) * (D / 8)), r = g % ((ZW - INW) * (D / 8));
          *(u32x4*)(w + ((size_t)l * ZW + INW) * D + (size_t)r * 8) = (u32x4){0u, 0u, 0u, 0u}; } }
    { bf16* wrt = WSP(bf16, WS_WRT); const float* wrg = CIN(IN_WRG); const float* wre = CIN(IN_WRE);
      for (int g = C.blk * NTHREADS + tid; g < 2 * 32 * (D / 8); g += C.G * NTHREADS) { const int l = g / (32 * (D / 8)), r = g % (32 * (D / 8)), c = r / (D / 8), k0 = (r % (D / 8)) * 8;
          float hi8[8], lo8[8];
#pragma unroll
          for (int e = 0; e < 8; ++e) { const int k = k0 + e; const float w = (c < 4) ? wrg[((size_t)l * D + k) * 4 + c] : ((c < 20) ? wre[((size_t)l * D + k) * 16 + (c - 4)] : 0.f);
              const float h = bf2f(f2bf(w)); hi8[e] = h; lo8[e] = w - h; }
          *(u32x4*)(wrt + ((size_t)(l * 2 + 0) * 32 + c) * D + k0) = pack8(hi8); *(u32x4*)(wrt + ((size_t)(l * 2 + 1) * 32 + c) * D + k0) = pack8(lo8); } }
    float* scr = (float*)lds + wave * (64 * 33);
    const int gw = C.blk * NWAVES + wave, NGW = C.G * NWAVES;
    for (int it = gw; it < 2 * IT_LAYER; it += NGW) {
        { const int l = it / IT_LAYER; int r = it - l * IT_LAYER;
            if (r < IT_WIN) { transpose_item(CIN(IN_WIN) + (size_t)l * D * INW, D, INW, WSP(bf16, WS_WIN) + (size_t)l * ZW * D, scr, r, lane, RmWin{}); continue; } r -= IT_WIN;
            if (r < IT_WOUT) { transpose_item(CIN(IN_WOUT) + (size_t)l * D * D, D, D, WSP(bf16, WS_WOUT) + (size_t)l * D * D, scr, r, lane, RmId{}); continue; } r -= IT_WOUT;
            if (r < IT_UQ) { transpose_item(CIN(IN_WUQ) + (size_t)l * 512 * 768, 512, 768, WSP(bf16, WS_WUQ) + (size_t)l * 768 * 512, scr, r, lane, RmUq{}); continue; } r -= IT_UQ;
            transpose_item(CIN(IN_WUKV) + (size_t)l * 256 * 1024, 256, 1024, WSP(bf16, WS_WUKV) + (size_t)l * 1024 * 256, scr, r, lane, RmId{});
        }
    }
}

__device__ __forceinline__ const float* x0_row(const float* x, const float* cx, int n) { return (n < NL) ? x + (size_t)n * D : cx + (size_t)(n - NL) * D; }
__device__ __forceinline__ int mod_set(int n) { return (n < NL) ? (n >> 13) : 2; }

__device__ __forceinline__ void phase_pre1(const Ctx& C) {
    PHASE_IDS();
    const int gw = C.blk * NWAVES + wave, NGW = C.G * NWAVES;
    const float* px = CIN(IN_X); const float* pcx = CIN(IN_CTX);
    for (int n = gw; n < M; n += NGW) {
        const int lane = opaque_tid() & 63;
        const float* xr = x0_row(px, pcx, n); const float* md = WSP(float, WS_MOD) + (size_t)mod_set(n) * 12288;
        bf16* hr = WSP(bf16, WS_HB) + (size_t)n * D;
#pragma unroll
        for (int j = 0; j < 4; ++j) { const int k = (lane + 64 * j) * 8;
            const f32x4 x0 = *(const f32x4*)(xr + k), x1 = *(const f32x4*)(xr + k + 4);
            const f32x4 s0 = *(const f32x4*)(md + 2048 + k), s1 = *(const f32x4*)(md + 2048 + k + 4), h0 = *(const f32x4*)(md + k), h1 = *(const f32x4*)(md + k + 4);
            const f32x4 a = x0 * (s0 + 1.f) + h0, b = x1 * (s1 + 1.f) + h1;
            u32x4 w; w.x = cvtpk(a[0], a[1]); w.y = cvtpk(a[2], a[3]); w.z = cvtpk(b[0], b[1]); w.w = cvtpk(b[2], b[3]);
            *(u32x4*)(hr + k) = w; }
    }
}


__device__ __forceinline__ void ld8f(const float* p, float (&f)[8]) { const f32x4 a = *(const f32x4*)p, b = *(const f32x4*)(p + 4); f[0] = a[0]; f[1] = a[1]; f[2] = a[2]; f[3] = a[3]; f[4] = b[0]; f[5] = b[1]; f[6] = b[2]; f[7] = b[3]; }
struct PostRaw { u32x4 q0, q1, kA, kB, cq, cA, cB; };
struct PostGains { float q0[8], q1[8], k0[8], k1[8], cq[8], ck[8]; };
__device__ __forceinline__ void post_load(const Ctx& C, int n, int lane, PostRaw& R) {
    const bf16* zr = WSP(bf16, WS_Z) + (size_t)n * ZW;
    const int h = lane >> 3, sub = lane & 7;
    R.q0 = *(const u32x4*)(zr + ZQG + h * 128 + sub * 8); R.q1 = *(const u32x4*)(zr + ZQG + h * 128 + 64 + sub * 8);
    const int ka = (lane < 16) ? (ZKG + h * 128 + sub * 8) : ((lane < 48) ? (ZVG + (lane - 16) * 8) : ZKG);
    R.kA = *(const u32x4*)(zr + ka); R.kB = *(const u32x4*)(zr + ((lane < 16) ? ka + 64 : ka));
    R.cq = *(const u32x4*)(zr + ZCQ + lane * 8);
    const int ca = (lane < 32) ? (ZCKV + lane * 8) : ((lane < 36) ? (ZKR + (lane - 32) * 8) : ZCKV);
    R.cA = *(const u32x4*)(zr + ca); R.cB = *(const u32x4*)(zr + ((lane >= 32 && lane < 36) ? ca + 32 : ca));
}
__device__ __forceinline__ void post_row(const Ctx& C, const PostGains& G, const PostRaw& R, int n, int lane) {
    const bool lat = n < NL;
#ifdef PROBE_NOROPE
    const bool dorope = false;
#else
    const bool dorope = lat;
#endif
    int b, pos, prow = 0, pcol = 0;
    if (lat) { b = n >> 13; const int t = n & (T - 1); pos = CTXL + t; prow = t >> 6; pcol = t & 63; } else { b = (n - NL) >> 8; pos = (n - NL) & 255; }
    const float* rpB = WSP(float, WS_ROPE); const float* rpC = rpB + 12288;
    const int h = lane >> 3, sub = lane & 7;
    float ct[8], st[8], c2[8], s2[8];
    { const float* ctp = (sub < 4) ? (rpB + prow * 32 + sub * 8) : (rpB + 8192 + pcol * 32 + (sub - 4) * 8); ld8f(ctp, ct); ld8f(ctp + ((sub < 4) ? 4096 : 2048), st);
      const int s4 = lane & 3; const float* ckp = (s4 < 2) ? (rpC + prow * 16 + s4 * 8) : (rpC + 4096 + pcol * 16 + (s4 - 2) * 8); ld8f(ckp, c2); ld8f(ckp + ((s4 < 2) ? 2048 : 1024), s2); }
    { float x1[8], x2[8]; unpack8(R.q0, x1); unpack8(R.q1, x2);
      float ss = 0.f;
#pragma unroll
      for (int e = 0; e < 8; ++e) ss += x1[e] * x1[e] + x2[e] * x2[e];
      ss += __shfl_xor(ss, 1); ss += __shfl_xor(ss, 2); ss += __shfl_xor(ss, 4);
      const float rinv = rsqrtf(ss * (1.f / 128.f) + RMS_EPS);
      float o1[8], o2[8];
      const float qs = rinv * 0.12751743f;
#pragma unroll
      for (int e = 0; e < 8; ++e) { const float a = x1[e] * qs * G.q0[e], c = x2[e] * qs * G.q1[e];
          o1[e] = dorope ? a * ct[e] - c * st[e] : a; o2[e] = dorope ? c * ct[e] + a * st[e] : c; }
      bf16* dst = WSP(bf16, WS_QG) + (size_t)n * 1024 + h * 128 + sub * 8;
      *(u32x4*)dst = pack8(o1); *(u32x4*)(dst + 64) = pack8(o2); }
    { float x1[8], x2[8]; unpack8(R.kA, x1); unpack8(R.kB, x2);
      float ss = 0.f;
#pragma unroll
      for (int e = 0; e < 8; ++e) ss += x1[e] * x1[e] + x2[e] * x2[e];
      ss += __shfl_xor(ss, 1); ss += __shfl_xor(ss, 2); ss += __shfl_xor(ss, 4);
      const float rinv = rsqrtf(ss * (1.f / 128.f) + RMS_EPS);
      float o1[8], o2[8];
#pragma unroll
      for (int e = 0; e < 8; ++e) { const float a = x1[e] * rinv * G.k0[e], c = x2[e] * rinv * G.k1[e];
          o1[e] = dorope ? a * ct[e] - c * st[e] : a; o2[e] = dorope ? c * ct[e] + a * st[e] : c; }
      if (lane < 16) { bf16* dst = WSP(bf16, WS_KG) + ((size_t)(b * 2 + h) * SKV + pos) * 128 + sub * 8;
          *(u32x4*)dst = pack8(o1); *(u32x4*)(dst + 64) = pack8(o2); }
      else if (lane < 48) { const int c = lane - 16;
          *(u32x4*)(WSP(bf16, WS_VG) + ((size_t)(b * 2 + (c >> 4)) * SKV + pos) * 128 + (c & 15) * 8) = R.kA; } }
    { float f[8]; unpack8(R.cq, f);
      float ss = 0.f;
#pragma unroll
      for (int e = 0; e < 8; ++e) ss += f[e] * f[e];
      ss = wave_sum(ss);
      const float rinv = rsqrtf(ss * (1.f / 512.f) + RMS_EPS);
#pragma unroll
      for (int e = 0; e < 8; ++e) f[e] = f[e] * rinv * G.cq[e];
      *(u32x4*)(WSP(bf16, WS_CQ) + (size_t)n * 512 + lane * 8) = pack8(f); }
    { float x1[8], x2[8]; unpack8(R.cA, x1); unpack8(R.cB, x2);
      float ss = 0.f;
#pragma unroll
      for (int e = 0; e < 8; ++e) ss += x1[e] * x1[e];
      ss = (lane < 32) ? ss : 0.f;
      ss += __shfl_xor(ss, 1); ss += __shfl_xor(ss, 2); ss += __shfl_xor(ss, 4); ss += __shfl_xor(ss, 8); ss += __shfl_xor(ss, 16);
      const float rinv = rsqrtf(ss * (1.f / 256.f) + RMS_EPS);
      if (lane < 32) { float f[8];
#pragma unroll
          for (int e = 0; e < 8; ++e) f[e] = x1[e] * rinv * G.ck[e];
          *(u32x4*)(WSP(bf16, WS_CKV) + (size_t)n * 256 + lane * 8) = pack8(f); }
      else if (lane < 36) { const int s4 = lane - 32;
          float o1[8], o2[8];
#pragma unroll
          for (int e = 0; e < 8; ++e) { o1[e] = dorope ? x1[e] * c2[e] - x2[e] * s2[e] : x1[e]; o2[e] = dorope ? x2[e] * c2[e] + x1[e] * s2[e] : x2[e]; }
          const u32x4 w1 = pack8(o1), w2 = pack8(o2);
#pragma unroll
          for (int hh = 0; hh < 4; ++hh) { bf16* dst = WSP(bf16, WS_KM) + ((size_t)(b * 4 + hh) * SKV + pos) * 192 + 128 + s4 * 8; *(u32x4*)dst = w1; *(u32x4*)(dst + 32) = w2; } } }
}
__device__ __forceinline__ void post_rows(const Ctx& C, int l) {
    PHASE_IDS();
    const int NGW = C.G * NWAVES;
    PostGains G;
    { const int sub = lane & 7; const float* bqn = CIN(IN_BQN) + l * 128; const float* bkn = CIN(IN_BKN) + l * 128;
      ld8f(bqn + sub * 8, G.q0); ld8f(bqn + 64 + sub * 8, G.q1); ld8f(bkn + sub * 8, G.k0); ld8f(bkn + 64 + sub * 8, G.k1);
      ld8f(CIN(IN_CQN) + l * 512 + lane * 8, G.cq); ld8f(CIN(IN_CKVN) + l * 256 + (lane & 31) * 8, G.ck); }
    int n = C.blk * NWAVES + wave;
    PostRaw cur; if (n < M) post_load(C, n, lane, cur);
    for (; n < M; n += NGW) {
        PostRaw nxt = cur; if (n + NGW < M) post_load(C, n + NGW, lane, nxt);
        post_row(C, G, cur, n, lane);
        cur = nxt;
    }
}

__device__ __forceinline__ void conv_silu16(const Ctx& C, int l, int row, int lo, int hi, int zcol, int cw, float scale, float (&o)[16]) {
    const bf16* z = WSP(bf16, WS_Z);
    const float* w = CIN(IN_CONVW) + (size_t)l * 3 * 512 + cw; const float* bb = CIN(IN_CONVB) + l * 512 + cw;
    float a[16], p[16], q[16];
    { const bf16* r = z + (size_t)row * ZW + zcol; float t0[8], t1[8]; unpack8(*(const u32x4*)r, t0); unpack8(*(const u32x4*)(r + 8), t1);
#pragma unroll
      for (int e = 0; e < 8; ++e) { a[e] = t0[e]; a[8 + e] = t1[e]; } }
    if (row - 1 >= lo) { const bf16* r = z + (size_t)(row - 1) * ZW + zcol; float t0[8], t1[8]; unpack8(*(const u32x4*)r, t0); unpack8(*(const u32x4*)(r + 8), t1);
#pragma unroll
      for (int e = 0; e < 8; ++e) { p[e] = t0[e]; p[8 + e] = t1[e]; } }
    else {
#pragma unroll
      for (int e = 0; e < 16; ++e) p[e] = 0.f; }
    if (row + 1 < hi) { const bf16* r = z + (size_t)(row + 1) * ZW + zcol; float t0[8], t1[8]; unpack8(*(const u32x4*)r, t0); unpack8(*(const u32x4*)(r + 8), t1);
#pragma unroll
      for (int e = 0; e < 8; ++e) { q[e] = t0[e]; q[8 + e] = t1[e]; } }
    else {
#pragma unroll
      for (int e = 0; e < 16; ++e) q[e] = 0.f; }
    float w0[16], w1[16], w2[16], b0[16];
#pragma unroll
    for (int e = 0; e < 16; e += 4) { const f32x4 t0 = *(const f32x4*)(w + e), t1 = *(const f32x4*)(w + 512 + e), t2 = *(const f32x4*)(w + 1024 + e), t3 = *(const f32x4*)(bb + e);
#pragma unroll
        for (int q4 = 0; q4 < 4; ++q4) { w0[e + q4] = t0[q4]; w1[e + q4] = t1[q4]; w2[e + q4] = t2[q4]; b0[e + q4] = t3[q4]; } }
#pragma unroll
    for (int e = 0; e < 16; ++e) { const float v = w0[e] * p[e] + w1[e] * a[e] + w2[e] * q[e] + b0[e]; o[e] = siluf_(v) * scale; }
}
__device__ __forceinline__ void chunk_geom(int b, int cp, int& row0, int& lo, int& hi) {
    if (cp < 2) { lo = NL + b * CTXL; hi = lo + CTXL; row0 = lo + cp * 128; } else { lo = b * T; hi = lo + T; row0 = lo + (cp - 2) * 128; }
}
__device__ __forceinline__ int scan_index(int cp, int d) { return d == 0 ? cp : (cp < 2 ? 1 - cp : 67 - cp); }
__device__ __forceinline__ void stage_gates(const Ctx& C, int l, int row0, int h, float* gi, float* glf, int tid) {
    if (tid < 128) { const bf16* r = WSP(bf16, WS_Z) + (size_t)(row0 + tid) * ZW + ZGATE;
        float t0[8], t1[8]; unpack8(*(const u32x4*)r, t0); unpack8(*(const u32x4*)(r + 8), t1);
        float g[16];
#pragma unroll
        for (int e = 0; e < 8; ++e) { g[e] = t0[e]; g[8 + e] = t1[e]; }
        float v0 = 0, v1 = 0, v2 = 0, v3 = 0;
#pragma unroll
        for (int hh = 0; hh < 4; ++hh) if (hh == h) { v0 = g[hh]; v1 = g[4 + hh]; v2 = g[8 + hh]; v3 = g[12 + hh]; }
        const float* gb = CIN(IN_GATEB) + l * 16;
        gi[tid] = v0 + gb[h]; gi[128 + tid] = v1 + gb[4 + h];
        glf[tid] = logsigmoidf_(v2 + gb[8 + h]); glf[128 + tid] = logsigmoidf_(v3 + gb[12 + h]); }
}
template <bool WITH_R>
__device__ __forceinline__ void gate_scan(int d, int lane, const float* gi, const float* glf, float* bc, float* uu, float* rr, float mprev, float& umax, float& blast) {
    const int p0 = d ? 127 - 2 * lane : 2 * lane, p1 = d ? 126 - 2 * lane : 2 * lane + 1;
    const float x0 = glf[d * 128 + p0], x1 = glf[d * 128 + p1];
    float inc = x0 + x1;
#pragma unroll
    for (int o = 1; o < 64; o <<= 1) { const float t = __shfl_up(inc, o); if (lane >= o) inc += t; }
    const float b1 = inc, b0 = inc - x1;
    const float u0 = gi[d * 128 + p0] - b0, u1 = gi[d * 128 + p1] - b1;
    bc[d * 128 + p0] = b0; bc[d * 128 + p1] = b1; uu[d * 128 + p0] = u0; uu[d * 128 + p1] = u1;
    float mx = fmaxf(u0, u1);
    if (WITH_R) { float cm = mx;
#pragma unroll
        for (int o = 1; o < 64; o <<= 1) { const float t = __shfl_up(cm, o); if (lane >= o) cm = fmaxf(cm, t); }
        float ex = __shfl_up(cm, 1); if (lane == 0) ex = -3.0e38f;
        const float r0 = fmaxf(mprev, fmaxf(ex, u0)), r1 = fmaxf(mprev, cm);
        rr[d * 128 + p0] = r0; rr[d * 128 + p1] = r1; }
#pragma unroll
    for (int o = 1; o < 64; o <<= 1) mx = fmaxf(mx, __shfl_xor(mx, o));
    umax = mx; blast = __shfl(b1, 63);
}

constexpr int ML_CW_OFF = 114688;
struct MlHead { u32x4 g0, g1, qa0, qa1, qp0, qp1, qq0, qq1, ka0, ka1, kp0, kp1, kq0, kq1, v0, v1, v2, v3; float cw, gb0, gb1, gb2, gb3; bool okp, okq; };
template <bool WITHQ>
__device__ __forceinline__ void ml_head_load(const Ctx& C, int l, int row0, int lo, int hi, int h, int tid, MlHead& H) {
    const bf16* z = WSP(bf16, WS_Z);
    const int pos = tid >> 2, part = tid & 3, row = row0 + pos;
    H.okp = row - 1 >= lo; H.okq = row + 1 < hi;
    const bf16* za = z + (size_t)row * ZW; const bf16* zp = z + (size_t)(H.okp ? row - 1 : row) * ZW; const bf16* zq = z + (size_t)(H.okq ? row + 1 : row) * ZW;
    const bf16* gr = z + (size_t)(row0 + (tid & 127)) * ZW + ZGATE;
    const int ck = ZMK + h * 64 + part * 16, cq = ZMQ + h * 64 + part * 16, cv = ZMV + h * 128 + part * 32;
    const int sec = tid >> 6, c = tid & 63;
    const float* cwp = (sec < 6) ? (CIN(IN_CONVW) + (size_t)l * 3 * 512 + (sec % 3) * 512 + (sec >= 3 ? 256 : 0) + h * 64 + c) : (CIN(IN_CONVB) + l * 512 + (sec == 7 ? 256 : 0) + h * 64 + c);
    const float* gb = CIN(IN_GATEB) + l * 16 + h;
    H.g0 = *(const u32x4*)gr; H.g1 = *(const u32x4*)(gr + 8);
    H.ka0 = *(const u32x4*)(za + ck); H.ka1 = *(const u32x4*)(za + ck + 8); H.kp0 = *(const u32x4*)(zp + ck); H.kp1 = *(const u32x4*)(zp + ck + 8); H.kq0 = *(const u32x4*)(zq + ck); H.kq1 = *(const u32x4*)(zq + ck + 8);
    if constexpr (WITHQ) { H.qa0 = *(const u32x4*)(za + cq); H.qa1 = *(const u32x4*)(za + cq + 8); H.qp0 = *(const u32x4*)(zp + cq); H.qp1 = *(const u32x4*)(zp + cq + 8); H.qq0 = *(const u32x4*)(zq + cq); H.qq1 = *(const u32x4*)(zq + cq + 8); }
    H.v0 = *(const u32x4*)(za + cv); H.v1 = *(const u32x4*)(za + cv + 8); H.v2 = *(const u32x4*)(za + cv + 16); H.v3 = *(const u32x4*)(za + cv + 24);
    H.cw = *cwp; H.gb0 = gb[0]; H.gb1 = gb[4]; H.gb2 = gb[8]; H.gb3 = gb[12];
    SBAR();
}
__device__ __forceinline__ void ml_head_stage(const MlHead& H, int h, int tid, float* gi, float* glf, float* cwl) {
    cwl[tid] = H.cw;
    if (tid < 128) { float t0[8], t1[8]; unpack8(H.g0, t0); unpack8(H.g1, t1);
        float g[16];
#pragma unroll
        for (int e = 0; e < 8; ++e) { g[e] = t0[e]; g[8 + e] = t1[e]; }
        float v0 = 0, v1 = 0, v2 = 0, v3 = 0;
#pragma unroll
        for (int hh = 0; hh < 4; ++hh) if (hh == h) { v0 = g[hh]; v1 = g[4 + hh]; v2 = g[8 + hh]; v3 = g[12 + hh]; }
        gi[tid] = v0 + H.gb0; gi[128 + tid] = v1 + H.gb1;
        glf[tid] = logsigmoidf_(v2 + H.gb2); glf[128 + tid] = logsigmoidf_(v3 + H.gb3); }
}
__device__ __forceinline__ void ml_conv16(const u32x4 a0, const u32x4 a1, const u32x4 p0, const u32x4 p1, const u32x4 q0, const u32x4 q1, bool okp, bool okq, const float* cwl, int sel, int part, float scale, float (&o)[16]) {
    float a[16], p[16], q[16];
    { float t0[8], t1[8]; unpack8(a0, t0); unpack8(a1, t1);
#pragma unroll
      for (int e = 0; e < 8; ++e) { a[e] = t0[e]; a[8 + e] = t1[e]; } }
    { float t0[8], t1[8]; unpack8(p0, t0); unpack8(p1, t1);
#pragma unroll
      for (int e = 0; e < 8; ++e) { p[e] = okp ? t0[e] : 0.f; p[8 + e] = okp ? t1[e] : 0.f; } }
    { float t0[8], t1[8]; unpack8(q0, t0); unpack8(q1, t1);
#pragma unroll
      for (int e = 0; e < 8; ++e) { q[e] = okq ? t0[e] : 0.f; q[8 + e] = okq ? t1[e] : 0.f; } }
    const float* w = cwl + sel * 192 + part * 16; const float* bb = cwl + (6 + sel) * 64 + part * 16;
#pragma unroll
    for (int e = 0; e < 16; e += 4) { const f32x4 t0 = *(const f32x4*)(w + e), t1 = *(const f32x4*)(w + 64 + e), t2 = *(const f32x4*)(w + 128 + e), t3 = *(const f32x4*)(bb + e);
#pragma unroll
        for (int q4 = 0; q4 < 4; ++q4) { const float v = t0[q4] * p[e + q4] + t1[q4] * a[e + q4] + t2[q4] * q[e + q4] + t3[q4]; o[e + q4] = siluf_(v) * scale; } }
}
__device__ __forceinline__ void ml_vscatter(const MlHead& H, bf16* vt, int pos, int part) {
    const u32x4 vv[4] = {H.v0, H.v1, H.v2, H.v3};
#pragma unroll
    for (int q = 0; q < 4; ++q) { const unsigned ww[4] = {vv[q].x, vv[q].y, vv[q].z, vv[q].w};
#pragma unroll
        for (int e = 0; e < 4; ++e) { vt[(part * 32 + q * 8 + 2 * e) * 136 + pos] = (bf16)(ww[e] & 0xffffu); vt[(part * 32 + q * 8 + 2 * e + 1) * 136 + pos] = (bf16)(ww[e] >> 16); } }
}
__device__ __forceinline__ void mlstm_a_unit(const Ctx& C, int l, int unit, char* lds) {
    const int b = unit / (4 * NCHUNK), h = (unit / NCHUNK) & 3, cp = unit % NCHUNK;
    int row0, lo, hi; chunk_geom(b, cp, row0, lo, hi);
    float* kk = (float*)lds;
    bf16* ktw = (bf16*)(lds + 32768);
    bf16* vt = (bf16*)(lds + 32768 + 34816);
    float* gi = (float*)(lds + 32768 + 2 * 34816);
    float* glf = gi + 256; float* bc = glf + 256; float* uu = bc + 256; float* wj = uu + 256; float* red = wj + 256;
    const int tid = opaque_tid(), lane = tid & 63, wid = __builtin_amdgcn_readfirstlane(tid >> 6);
    float* cwl = (float*)(lds + ML_CW_OFF);
    { MlHead H; ml_head_load<false>(C, l, row0, lo, hi, h, tid, H);
      ml_head_stage(H, h, tid, gi, glf, cwl);
      const int pos = tid >> 2, part = tid & 3;
      ml_vscatter(H, vt, pos, part);
      __syncthreads();
      float o[16];
      ml_conv16(H.ka0, H.ka1, H.kp0, H.kp1, H.kq0, H.kq1, H.okp, H.okq, cwl, 1, part, 0.125f, o);
#pragma unroll
      for (int e = 0; e < 16; e += 4) *(f32x4*)(kk + pos * 64 + part * 16 + e) = (f32x4){o[e], o[e + 1], o[e + 2], o[e + 3]}; }
    __syncthreads();
    if (wid < 2) { const int d = wid; float umax, blast;
        gate_scan<false>(d, lane, gi, glf, bc, uu, nullptr, 0.f, umax, blast);
        LDS_WAIT();
        wj[d * 128 + 2 * lane] = __expf(uu[d * 128 + 2 * lane] - umax); wj[d * 128 + 2 * lane + 1] = __expf(uu[d * 128 + 2 * lane + 1] - umax);
        if (lane == 0) { float* st = WSP(float, WS_USTAT) + ((size_t)((b * 4 + h) * 2 + d) * NCHUNK + scan_index(cp, d)) * 2; st[0] = umax; st[1] = blast; } }
    __syncthreads();
    { const int dk = tid & 63, pg = tid >> 6;
#pragma unroll
      for (int d = 0; d < 2; ++d) { float v[16]; float pn = 0.f;
#pragma unroll
          for (int e = 0; e < 16; ++e) { v[e] = wj[d * 128 + pg * 16 + e] * kk[(pg * 16 + e) * 64 + dk]; pn += v[e]; }
          bf16* dst = ktw + d * (64 * 136) + dk * 136 + pg * 16;
          u32x4 w0, w1; w0.x = cvtpk(v[0], v[1]); w0.y = cvtpk(v[2], v[3]); w0.z = cvtpk(v[4], v[5]); w0.w = cvtpk(v[6], v[7]);
          w1.x = cvtpk(v[8], v[9]); w1.y = cvtpk(v[10], v[11]); w1.z = cvtpk(v[12], v[13]); w1.w = cvtpk(v[14], v[15]);
          *(u32x4*)dst = w0; *(u32x4*)(dst + 8) = w1;
          red[(d * 8 + pg) * 64 + dk] = pn; } }
    __syncthreads();
    if (tid < 128) { const int d = tid >> 6, dk = tid & 63; float a = 0.f;
#pragma unroll
        for (int q = 0; q < 8; ++q) a += red[(d * 8 + q) * 64 + dk];
        WSP(float, WS_UN)[((size_t)((b * 4 + h) * 2 + d) * NCHUNK + scan_index(cp, d)) * 64 + dk] = a; }
    { const int tm = wid >> 1, tn = wid & 1, r32 = lane & 31, hi2 = lane >> 5;
#pragma unroll
      for (int d = 0; d < 2; ++d) { f32x16 acc = {};
#pragma unroll
          for (int ks = 0; ks < 8; ++ks) { const bf16x8 A = *(const bf16x8*)(vt + (32 * tm + r32) * 136 + 16 * ks + 8 * hi2);
              const bf16x8 B = *(const bf16x8*)(ktw + d * (64 * 136) + (32 * tn + r32) * 136 + 16 * ks + 8 * hi2);
              acc = __builtin_amdgcn_mfma_f32_32x32x16_bf16(A, B, acc, 0, 0, 0); }
          float* U = WSP(float, WS_U) + ((size_t)((b * 4 + h) * 2 + d) * NCHUNK + scan_index(cp, d)) * 8192;
#pragma unroll
          for (int r = 0; r < 16; ++r) U[(32 * tm + att::crow(r, hi2)) * 64 + 32 * tn + r32] = acc[r]; } }
    __syncthreads();
}

__device__ __forceinline__ void mlstm_scan(const Ctx& C) {
    PHASE_IDS();
    const float* ST = WSP(float, WS_USTAT);
    for (int e = C.blk * NTHREADS + tid; e < 16 * 8192; e += C.G * NTHREADS) {
        const bool two = e < 16 * 64;
        const int chain0 = e >> 13, el0 = e & 8191, chain1 = two ? (e >> 6) : chain0, el1 = e & 63;
        const float* src0 = WSP(float, WS_U) + (size_t)chain0 * NCHUNK * 8192 + el0;
        const float* src1 = WSP(float, WS_UN) + (size_t)chain1 * NCHUNK * 64 + el1;
        float c0 = 0.f, m0 = 0.f, c1 = 0.f, m1 = 0.f;
#pragma unroll 1
        for (int s0 = 0; s0 < NCHUNK; s0 += 11) {
            float u0[11], um0[11], bl0[11], u1[11], um1[11], bl1[11];
#pragma unroll
            for (int q = 0; q < 11; ++q) { u0[q] = src0[(size_t)(s0 + q) * 8192]; um0[q] = ST[(chain0 * NCHUNK + s0 + q) * 2]; bl0[q] = ST[(chain0 * NCHUNK + s0 + q) * 2 + 1];
                if (two) { u1[q] = src1[(size_t)(s0 + q) * 64]; um1[q] = ST[(chain1 * NCHUNK + s0 + q) * 2]; bl1[q] = ST[(chain1 * NCHUNK + s0 + q) * 2 + 1]; } else { u1[q] = 0.f; um1[q] = 0.f; bl1[q] = 0.f; } }
#pragma unroll
            for (int q = 0; q < 11; ++q) { const int s = s0 + q;
                WSP(bf16, WS_CST)[((size_t)chain0 * NCHUNK + s) * 8192 + el0] = f2bf(c0); if (el0 == 0) WSP(float, WS_MST)[chain0 * NCHUNK + s] = m0;
                { const float mx = fmaxf(m0, um0[q]); c0 = __expf(m0 - mx) * c0 + __expf(um0[q] - mx) * u0[q]; m0 = bl0[q] + mx; }
                if (two) { WSP(float, WS_NST)[((size_t)chain1 * NCHUNK + s) * 64 + el1] = c1;
                    const float mx = fmaxf(m1, um1[q]); c1 = __expf(m1 - mx) * c1 + __expf(um1[q] - mx) * u1[q]; m1 = bl1[q] + mx; } }
        }
    }
}

__device__ __forceinline__ void mlstm_scan_window(const Ctx& C, int b0, int nb) {
    PHASE_IDS();
    if (C.blk < b0 || C.blk >= b0 + nb) return;
    const float* ST = WSP(float, WS_USTAT);
    const int gt = (C.blk - b0) * NTHREADS + tid, nthr = nb * NTHREADS;
    for (int e8 = gt; e8 < (16 * 8192 + 16 * 64) / 8; e8 += nthr) {
        const bool isn = e8 >= 16 * 8192 / 8;
        const int ee = (isn ? e8 - 16 * 8192 / 8 : e8) * 8, chain = isn ? (ee >> 6) : (ee >> 13), el = isn ? (ee & 63) : (ee & 8191), stride = isn ? 64 : 8192;
        const float* src = (isn ? WSP(float, WS_UN) : WSP(float, WS_U)) + (size_t)chain * NCHUNK * stride + el;
        f32x4 c0 = {0.f, 0.f, 0.f, 0.f}, c1 = c0; float m = 0.f;
#pragma unroll 1
        for (int s0 = 0; s0 < NCHUNK; s0 += 11) {
            f32x4 u0[11], u1[11]; float um[11], bl[11];
#pragma unroll
            for (int q = 0; q < 11; ++q) { u0[q] = *(const f32x4*)(src + (size_t)(s0 + q) * stride); u1[q] = *(const f32x4*)(src + (size_t)(s0 + q) * stride + 4);
                um[q] = ST[(chain * NCHUNK + s0 + q) * 2]; bl[q] = ST[(chain * NCHUNK + s0 + q) * 2 + 1]; }
#pragma unroll
            for (int q = 0; q < 11; ++q) { const int s = s0 + q;
                if (isn) { float* d = WSP(float, WS_NST) + ((size_t)chain * NCHUNK + s) * 64 + el; *(f32x4*)d = c0; *(f32x4*)(d + 4) = c1; }
                else { u32x4 w; w.x = cvtpk(c0[0], c0[1]); w.y = cvtpk(c0[2], c0[3]); w.z = cvtpk(c1[0], c1[1]); w.w = cvtpk(c1[2], c1[3]);
                    *(u32x4*)(WSP(bf16, WS_CST) + ((size_t)chain * NCHUNK + s) * 8192 + el) = w; if (el == 0) WSP(float, WS_MST)[chain * NCHUNK + s] = m; }
                const float mx = fmaxf(m, um[q]); const float a = __expf(m - mx), bb = __expf(um[q] - mx);
                c0 = c0 * a + u0[q] * bb; c1 = c1 * a + u1[q] * bb; m = bl[q] + mx; }
        }
    }
}

__device__ __forceinline__ void mlstm_c_unit(const Ctx& C, int l, int unit, char* lds) {
    const int b = unit / (4 * NCHUNK), h = (unit / NCHUNK) & 3, cp = unit % NCHUNK;
    int row0, lo, hi; chunk_geom(b, cp, row0, lo, hi);
    bf16* Qs = (bf16*)lds;
    bf16* Ks = (bf16*)(lds + 18432);
    bf16* vt = (bf16*)(lds + 36864);
    bf16* Pw = (bf16*)(lds + 36864 + 34816);
    float* gi = (float*)(lds + 36864 + 2 * 34816);
    float* glf = gi + 256; float* bc = glf + 256; float* uu = bc + 256; float* rr = uu + 256; float* npv = rr + 256;
    float* wsc = npv + 128;
    const int tid = opaque_tid(), lane = tid & 63, wid = __builtin_amdgcn_readfirstlane(tid >> 6);
    float* cwl = (float*)(lds + ML_CW_OFF);
    { MlHead H; ml_head_load<true>(C, l, row0, lo, hi, h, tid, H);
      const float npvv = WSP(float, WS_NST)[((size_t)((b * 4 + h) * 2 + ((tid >> 6) & 1)) * NCHUNK + scan_index(cp, (tid >> 6) & 1)) * 64 + (tid & 63)];
      ml_head_stage(H, h, tid, gi, glf, cwl);
      const int pos = tid >> 2, part = tid & 3;
      ml_vscatter(H, vt, pos, part);
      if (tid < 128) npv[tid] = npvv;
      __syncthreads();
      float o[16];
      ml_conv16(H.qa0, H.qa1, H.qp0, H.qp1, H.qq0, H.qq1, H.okp, H.okq, cwl, 0, part, 1.f, o);
      { u32x4 w0, w1; w0.x = cvtpk(o[0], o[1]); w0.y = cvtpk(o[2], o[3]); w0.z = cvtpk(o[4], o[5]); w0.w = cvtpk(o[6], o[7]);
        w1.x = cvtpk(o[8], o[9]); w1.y = cvtpk(o[10], o[11]); w1.z = cvtpk(o[12], o[13]); w1.w = cvtpk(o[14], o[15]);
        *(u32x4*)(Qs + pos * 72 + part * 16) = w0; *(u32x4*)(Qs + pos * 72 + part * 16 + 8) = w1; }
      ml_conv16(H.ka0, H.ka1, H.kp0, H.kp1, H.kq0, H.kq1, H.okp, H.okq, cwl, 1, part, 0.125f, o);
      { u32x4 w0, w1; w0.x = cvtpk(o[0], o[1]); w0.y = cvtpk(o[2], o[3]); w0.z = cvtpk(o[4], o[5]); w0.w = cvtpk(o[6], o[7]);
        w1.x = cvtpk(o[8], o[9]); w1.y = cvtpk(o[10], o[11]); w1.z = cvtpk(o[12], o[13]); w1.w = cvtpk(o[14], o[15]);
        *(u32x4*)(Ks + pos * 72 + part * 16) = w0; *(u32x4*)(Ks + pos * 72 + part * 16 + 8) = w1; } }
    __syncthreads();
    float mprev[2];
#pragma unroll
    for (int d = 0; d < 2; ++d) mprev[d] = WSP(float, WS_MST)[((b * 4 + h) * 2 + d) * NCHUNK + scan_index(cp, d)];
    if (wid < 2) { float umax, blast; gate_scan<true>(wid, lane, gi, glf, bc, uu, rr, wid == 0 ? mprev[0] : mprev[1], umax, blast); }
    __syncthreads();
    const int il = lane & 15, g4 = lane >> 4, ig = 16 * wid + il;
    unsigned short ogv[8][4];
#pragma unroll
    for (int nb = 0; nb < 8; ++nb)
#pragma unroll
        for (int r = 0; r < 4; ++r) ogv[nb][r] = WSP(bf16, WS_Z)[(size_t)(row0 + 16 * wid + 4 * g4 + r) * ZW + ZOG + h * 128 + 16 * nb + il];
    bf16x8 qf[2];
#pragma unroll
    for (int ks = 0; ks < 2; ++ks) qf[ks] = *(const bf16x8*)(Qs + ig * 72 + 32 * ks + 8 * g4);
    bf16* Pme = Pw + wid * (16 * 136); float* sc = wsc + wid * 16;
    f32x4 hacc[8];
#pragma unroll
    for (int nb = 0; nb < 8; ++nb) hacc[nb] = (f32x4){0.f, 0.f, 0.f, 0.f};
#pragma unroll
    for (int d = 0; d < 2; ++d) {
        const float r_i = rr[d * 128 + ig], b_i = bc[d * 128 + ig];
        const float wprev = __expf(mprev[d] - r_i);
        float qn = 0.f;
#pragma unroll
        for (int ks = 0; ks < 2; ++ks)
#pragma unroll
            for (int e = 0; e < 8; ++e) qn += bf2f((unsigned short)qf[ks][e]) * npv[d * 64 + 32 * ks + 8 * g4 + e];
        qn += __shfl_xor(qn, 16); qn += __shfl_xor(qn, 32);
        f32x4 acc[8];
        const bf16* Cp = WSP(bf16, WS_CST) + ((size_t)((b * 4 + h) * 2 + d) * NCHUNK + scan_index(cp, d)) * 8192;
        bf16x8 cf[8][2];
#pragma unroll
        for (int nb = 0; nb < 8; ++nb)
#pragma unroll
            for (int ks = 0; ks < 2; ++ks) cf[nb][ks] = *(const bf16x8*)(Cp + (16 * nb + il) * 64 + 32 * ks + 8 * g4);
        if (lane < 16) sc[16 * 8 + il] = wprev;
        float rsum = 0.f;
#pragma unroll
        for (int jb = 0; jb < 8; ++jb) { f32x4 s = {0.f, 0.f, 0.f, 0.f};
#pragma unroll
            for (int ks = 0; ks < 2; ++ks) { const bf16x8 kf = *(const bf16x8*)(Ks + (16 * jb + il) * 72 + 32 * ks + 8 * g4);
                s = __builtin_amdgcn_mfma_f32_16x16x32_bf16(kf, qf[ks], s, 0, 0, 0); }
            const f32x4 u4 = *(const f32x4*)(uu + d * 128 + 16 * jb + 4 * g4);
            float p[4];
#pragma unroll
            for (int r = 0; r < 4; ++r) { const int j = 16 * jb + 4 * g4 + r; const bool ok = d ? (j >= ig) : (j <= ig);
                p[r] = ok ? s[r] * __expf(u4[r] - r_i) : 0.f; rsum += p[r]; }
            u32x2 w; w.x = cvtpk(p[0], p[1]); w.y = cvtpk(p[2], p[3]);
            *(u32x2*)(Pme + il * 136 + 16 * jb + 4 * g4) = w; }
        rsum += __shfl_xor(rsum, 16); rsum += __shfl_xor(rsum, 32);
        const float den = rsum + wprev * qn;
        const float dn = fmaxf(fabsf(den), __expf(-b_i - r_i));
        LDS_WAIT();
        if (lane < 16) sc[il] = 1.f / dn;
        LDS_WAIT();
#pragma unroll
        for (int nb = 0; nb < 8; ++nb) { acc[nb] = (f32x4){0.f, 0.f, 0.f, 0.f};
#pragma unroll
            for (int ks = 0; ks < 2; ++ks) acc[nb] = __builtin_amdgcn_mfma_f32_16x16x32_bf16(qf[ks], cf[nb][ks], acc[nb], 0, 0, 0); }
        { const f32x4 wp4 = *(const f32x4*)(sc + 16 * 8 + 4 * g4);
#pragma unroll
          for (int nb = 0; nb < 8; ++nb) acc[nb] *= wp4; }
#pragma unroll
        for (int ks = 0; ks < 4; ++ks) { const bf16x8 pf = *(const bf16x8*)(Pme + il * 136 + 32 * ks + 8 * g4);
#pragma unroll
            for (int nb = 0; nb < 8; ++nb) { const bf16x8 vf = *(const bf16x8*)(vt + (16 * nb + il) * 136 + 32 * ks + 8 * g4);
                acc[nb] = __builtin_amdgcn_mfma_f32_16x16x32_bf16(pf, vf, acc[nb], 0, 0, 0); } }
        { const f32x4 inv4 = *(const f32x4*)(sc + 4 * g4);
#pragma unroll
          for (int nb = 0; nb < 8; ++nb) hacc[nb] += acc[nb] * inv4; }
        LDS_WAIT();
    }
    f32x4 sum = {0.f, 0.f, 0.f, 0.f};
#pragma unroll
    for (int nb = 0; nb < 8; ++nb) sum += hacc[nb];
#pragma unroll
    for (int r = 0; r < 4; ++r) { float s = sum[r]; s += __shfl_xor(s, 1); s += __shfl_xor(s, 2); s += __shfl_xor(s, 4); s += __shfl_xor(s, 8); sum[r] = s * (1.f / 128.f); }
    f32x4 sq = {0.f, 0.f, 0.f, 0.f};
#pragma unroll
    for (int nb = 0; nb < 8; ++nb) { const f32x4 dd = hacc[nb] - sum; sq += dd * dd; }
#pragma unroll
    for (int r = 0; r < 4; ++r) { float s = sq[r]; s += __shfl_xor(s, 1); s += __shfl_xor(s, 2); s += __shfl_xor(s, 4); s += __shfl_xor(s, 8); sq[r] = rsqrtf(s * (1.f / 128.f) + LN_EPS); }
    const float* ng = CIN(IN_ANORM) + l * 512 + h * 128;
    float gnv[8];
#pragma unroll
    for (int nb = 0; nb < 8; ++nb) gnv[nb] = ng[16 * nb + il];
#pragma unroll
    for (int nb = 0; nb < 8; ++nb) { const int dv = 16 * nb + il; const float gn = gnv[nb];
#pragma unroll
        for (int r = 0; r < 4; ++r) { const size_t row = (size_t)(row0 + 16 * wid + 4 * g4 + r);
            const float og = bf2f(ogv[nb][r]);
            WSP(bf16, WS_MIX)[row * D + h * 128 + dv] = f2bf((hacc[nb][r] - sum[r]) * sq[r] * gn * sigmoidf_(og)); } }
    __syncthreads();
}

__device__ __forceinline__ void phase_ln1(const Ctx& C, int l, char* lds) {
    PHASE_IDS();
    const int rows_total = (l == 0) ? M : NL;
    const int rpb = (rows_total + C.G - 1) / C.G, r_lo = C.blk * rpb, r_hi = (r_lo + rpb < rows_total) ? r_lo + rpb : rows_total;
    constexpr int TROW = 2056;
    bf16* TH = (bf16*)lds;
    bf16* TL = TH + 8 * TROW;
    float* RED = (float*)(lds + 2 * 8 * TROW * 2);
    int* lcnt = (int*)(RED + 8 * 8 * 32);
    int* gbase = lcnt + 16;
    int* rinfo = gbase + 16;
    float* rwt = (float*)(rinfo + 4 * 72);
    float* PV = rwt + 2 * 72;
    const int s_lo = mod_set(r_lo), s_hi = mod_set(r_hi > r_lo ? r_hi - 1 : r_lo);
    { const float* lg_ = CIN(IN_LN1G) + l * D; const float* lb_ = CIN(IN_LN1B) + l * D; const float* md_all_ = WSP(float, WS_MOD) + (size_t)l * 3 * 12288;
      for (int i = tid; i < 8 * (D / 4); i += NTHREADS) { const int v = i / (D / 4), k = (i % (D / 4)) * 4; f32x4 x;
          if (v == 0) x = *(const f32x4*)(lg_ + k); else if (v == 1) x = *(const f32x4*)(lb_ + k);
          else { const int sset = ((v - 2) / 3 == 0) ? s_lo : s_hi, q = (v - 2) % 3; x = *(const f32x4*)(md_all_ + (size_t)sset * 12288 + (2 + q) * 2048 + k); }
          *(f32x4*)(PV + v * D + k) = x; } }
    if (tid < 16) lcnt[tid] = 0;
    __syncthreads();
    const float* px = CIN(IN_X); const float* pcx = CIN(IN_CTX); const float* brg = CIN(IN_BRG) + l * 4; const float* bre = CIN(IN_BRE) + l * 16;
    const bf16* wrh = WSP(bf16, WS_WRT) + (size_t)(l * 2 + 0) * 32 * D; const bf16* wrl = WSP(bf16, WS_WRT) + (size_t)(l * 2 + 1) * 32 * D;
    f32x4 cx[8]; u32x2 cy[8];
#define LN1_LOAD(nn, X, Y) do { const float* xr_ = (l == 0) ? x0_row(px, pcx, (nn)) : (WSP(float, WS_XRES) + (size_t)(nn) * D); const bf16* yr_ = WSP(bf16, WS_Y) + (size_t)(nn) * D; \
        _Pragma("unroll") for (int j = 0; j < 8; ++j) { const int k = 4 * lane + 256 * j; X[j] = *(const f32x4*)(xr_ + k); Y[j] = *(const u32x2*)(yr_ + k); } } while (0)
    if (r_lo + wave < r_hi) LN1_LOAD(r_lo + wave, cx, cy);
    for (int n0 = r_lo; n0 < r_hi; n0 += NWAVES) {
        const int n = n0 + wave; const bool valid = n < r_hi;
        f32x4 nx[8]; u32x2 ny[8];
#pragma unroll
        for (int j = 0; j < 8; ++j) { nx[j] = cx[j]; ny[j] = cy[j]; }
        if (n + NWAVES < r_hi) LN1_LOAD(n + NWAVES, nx, ny);
        f32x4 sx[8]; u32x2 st_[8];
        if (valid) {
            const float* pm = PV + (2 + ((mod_set(n) == s_lo) ? 0 : 3)) * D;
            f32x4 v[8]; float s = 0.f;
#pragma unroll
            for (int j = 0; j < 8; ++j) { const int k = 4 * lane + 256 * j;
                const f32x4 x = cx[j]; const u32x2 yw = cy[j]; const f32x4 g2 = *(const f32x4*)(pm + k);
                const f32x4 y = {bflo(yw.x), bfhi(yw.x), bflo(yw.y), bfhi(yw.y)};
                v[j] = x * ALPHA + g2 * y; s += (v[j][0] + v[j][1]) + (v[j][2] + v[j][3]); }
            const float mean = wave_sum(s) * (1.f / D); float s2 = 0.f;
#pragma unroll
            for (int j = 0; j < 8; ++j) { v[j] = v[j] - mean; s2 += (v[j][0] * v[j][0] + v[j][1] * v[j][1]) + (v[j][2] * v[j][2] + v[j][3] * v[j][3]); }
            const float rstd = rsqrtf(wave_sum(s2) * (1.f / D) + LN_EPS);
#pragma unroll
            for (int j = 0; j < 8; ++j) { const int k = 4 * lane + 256 * j;
                const f32x4 x1 = v[j] * rstd * *(const f32x4*)(PV + k) + *(const f32x4*)(PV + D + k);
                sx[j] = x1;
                const f32x4 tt = x1 * (*(const f32x4*)(pm + 2 * D + k) + 1.f) + *(const f32x4*)(pm + D + k);
                u32x2 wh; wh.x = cvtpk(tt[0], tt[1]); wh.y = cvtpk(tt[2], tt[3]);
                st_[j] = wh;
                u32x2 wl; wl.x = cvtpk(tt[0] - bflo(wh.x), tt[1] - bfhi(wh.x)); wl.y = cvtpk(tt[2] - bflo(wh.y), tt[3] - bfhi(wh.y));
                *(u32x2*)(TH + wave * TROW + k) = wh; *(u32x2*)(TL + wave * TROW + k) = wl; }
        } else {
#pragma unroll
            for (int j = 0; j < 8; ++j) { const int k = 4 * lane + 256 * j; *(u32x2*)(TH + wave * TROW + k) = (u32x2){0u, 0u}; *(u32x2*)(TL + wave * TROW + k) = (u32x2){0u, 0u}; }
        }
        { const int il = lane & 15, g4 = lane >> 4, r8 = il & 7;
          bf16x8 wq[4][4];
#define LN1_WLOAD(ks0_) do { _Pragma("unroll") for (int ks = 0; ks < 4; ++ks) { const int k = 256 * wave + 32 * ((ks0_) + ks) + 8 * g4; \
              wq[ks][0] = *(const bf16x8*)(wrh + (size_t)il * D + k); wq[ks][1] = *(const bf16x8*)(wrl + (size_t)il * D + k); \
              wq[ks][2] = *(const bf16x8*)(wrh + (size_t)(16 + il) * D + k); wq[ks][3] = *(const bf16x8*)(wrl + (size_t)(16 + il) * D + k); } } while (0)
#define LN1_WMMA(ks0_) do { _Pragma("unroll") for (int ks = 0; ks < 4; ++ks) { const int k = 256 * wave + 32 * ((ks0_) + ks) + 8 * g4; \
              const bf16x8 ah = *(const bf16x8*)(TH + r8 * TROW + k), al = *(const bf16x8*)(TL + r8 * TROW + k); \
              acc0 = __builtin_amdgcn_mfma_f32_16x16x32_bf16(ah, wq[ks][0], acc0, 0, 0, 0); acc0 = __builtin_amdgcn_mfma_f32_16x16x32_bf16(al, wq[ks][0], acc0, 0, 0, 0); acc0 = __builtin_amdgcn_mfma_f32_16x16x32_bf16(ah, wq[ks][1], acc0, 0, 0, 0); \
              acc1 = __builtin_amdgcn_mfma_f32_16x16x32_bf16(ah, wq[ks][2], acc1, 0, 0, 0); acc1 = __builtin_amdgcn_mfma_f32_16x16x32_bf16(al, wq[ks][2], acc1, 0, 0, 0); acc1 = __builtin_amdgcn_mfma_f32_16x16x32_bf16(ah, wq[ks][3], acc1, 0, 0, 0); } } while (0)
          LN1_WLOAD(0); SBAR();
          LDS_BARRIER();
          f32x4 acc0 = {0.f, 0.f, 0.f, 0.f}, acc1 = acc0;
          LN1_WMMA(0); SBAR();
          LN1_WLOAD(4); SBAR();
          LN1_WMMA(4); SBAR();
#undef LN1_WLOAD
#undef LN1_WMMA
          if (g4 < 2) {
#pragma unroll
              for (int r = 0; r < 4; ++r) { RED[(wave * 8 + 4 * g4 + r) * 32 + il] = acc0[r]; RED[(wave * 8 + 4 * g4 + r) * 32 + 16 + il] = acc1[r]; } } }
        if (valid) {
#pragma unroll
            for (int j = 0; j < 8; ++j) { const int k = 4 * lane + 256 * j;
                __builtin_nontemporal_store(sx[j], (f32x4*)(WSP(float, WS_XRES) + (size_t)n * D + k));
                __builtin_nontemporal_store(st_[j], (u32x2*)(WSP(bf16, WS_HB) + (size_t)n * D + k)); } }
        LDS_BARRIER();
        { float lv = 0.f;
          if (lane < 32) {
#pragma unroll
              for (int q = 0; q < 8; ++q) lv += RED[(q * 8 + wave) * 32 + lane]; }
          float lgt[20];
#pragma unroll
          for (int q = 0; q < 20; ++q) lgt[q] = __shfl(lv, q);
          if (valid) {
            float gl[4]; int gidx = 0; float gmax;
#pragma unroll
            for (int q = 0; q < 4; ++q) gl[q] = lgt[q] + brg[q];
            gmax = gl[0];
#pragma unroll
            for (int q = 1; q < 4; ++q) if (gl[q] > gmax) { gmax = gl[q]; gidx = q; }
            float gs = 0.f;
#pragma unroll
            for (int q = 0; q < 4; ++q) gs += __expf(gl[q] - gmax);
            const float gw = 1.f / gs;
            float ein[4] = {0.f, 0.f, 0.f, 0.f};
#pragma unroll
            for (int gq = 0; gq < 4; ++gq)
#pragma unroll
                for (int q = 0; q < 4; ++q) ein[q] = (gidx == gq) ? (lgt[4 + 4 * gq + q] + bre[4 * gq + q]) : ein[q];
            int i0 = 0; float m0 = ein[0];
#pragma unroll
            for (int q = 1; q < 4; ++q) if (ein[q] > m0) { m0 = ein[q]; i0 = q; }
            int i1 = -1; float m1 = -3.0e38f;
#pragma unroll
            for (int q = 0; q < 4; ++q) if (q != i0 && ein[q] > m1) { m1 = ein[q]; i1 = q; }
            const float p1 = __expf(m1 - m0);
            const float w0 = gw / (1.f + p1), w1 = gw * p1 / (1.f + p1);
            if (lane == 0) { const int e0 = gidx * 4 + i0, e1 = gidx * 4 + i1, r = n - r_lo;
                const int k0 = atomicAdd(&lcnt[e0], 1), k1 = atomicAdd(&lcnt[e1], 1);
                rinfo[4 * r] = e0; rinfo[4 * r + 1] = k0; rinfo[4 * r + 2] = e1; rinfo[4 * r + 3] = k1; rwt[2 * r] = w0; rwt[2 * r + 1] = w1; }
          } }
#pragma unroll
        for (int j = 0; j < 8; ++j) { cx[j] = nx[j]; cy[j] = ny[j]; }
    }
#undef LN1_LOAD
    __syncthreads();
    if (tid < 16) gbase[tid] = (int)__hip_atomic_fetch_add((unsigned*)(C.ws + WS_CTL) + CW_CNT + l * 16 + tid, (unsigned)lcnt[tid], __ATOMIC_RELAXED, __HIP_MEMORY_SCOPE_AGENT);
    __syncthreads();
    for (int r = tid; r < r_hi - r_lo; r += NTHREADS) { const int n = r_lo + r;
#pragma unroll
        for (int q = 0; q < 2; ++q) { const int e = rinfo[4 * r + 2 * q], pos = gbase[e] + rinfo[4 * r + 2 * q + 1];
            WSP(int, WS_LIST)[(size_t)e * M + pos] = n; WSP(float, WS_ROWW)[(size_t)e * M + pos] = rwt[2 * r + q];
            WSP(int, WS_TSLOT)[2 * n + q] = (e << 20) | pos; } }
    __syncthreads();
}
__device__ __forceinline__ void moe_tables(const Ctx& C, int l, char* lds) {
    int* tpg = (int*)(lds + LDS_MISC + 64); int* cng = (int*)(lds + LDS_MISC + 136);
    const int t = opaque_tid();
    if (t < 16) cng[t] = (int)__hip_atomic_load((unsigned*)(C.ws + WS_CTL) + CW_CNT + l * 16 + t, __ATOMIC_RELAXED, __HIP_MEMORY_SCOPE_AGENT);
    __syncthreads();
    if (t == 0) { int a = 0; tpg[0] = 0; for (int e = 0; e < 16; ++e) { a += (cng[e] + 255) >> 8; tpg[e + 1] = a; } }
    __syncthreads();
}
struct Ln2Raw { f32x4 x[8]; u32x2 fa[8], fb[8]; };
__device__ __forceinline__ void ln2_load(const Ctx& C, const int* tpg, int n, int lane, Ln2Raw& R) {
    const int ts0 = WSP(int, WS_TSLOT)[2 * n], ts1 = WSP(int, WS_TSLOT)[2 * n + 1];
    const size_t s0 = (size_t)tpg[ts0 >> 20] * 256 + (ts0 & 0xFFFFF), s1 = (size_t)tpg[ts1 >> 20] * 256 + (ts1 & 0xFFFFF);
    const bf16* f0 = WSP(bf16, WS_FSLOT) + s0 * D; const bf16* f1 = WSP(bf16, WS_FSLOT) + s1 * D;
    const float* xr = WSP(float, WS_XRES) + (size_t)n * D;
#pragma unroll
    for (int j = 0; j < 8; ++j) { const int k = 4 * lane + 256 * j; R.x[j] = *(const f32x4*)(xr + k); R.fa[j] = *(const u32x2*)(f0 + k); R.fb[j] = *(const u32x2*)(f1 + k); }
}
__device__ __forceinline__ void phase_ln2(const Ctx& C, int l, char* lds) {
    const int rows_total = (l == 0) ? M : NL;
    const int* tpg = (const int*)(lds + LDS_MISC + 64);
    float* PV = (float*)lds;
    { const int t = opaque_tid(); const float* lg = CIN(IN_LN2G) + l * D; const float* lb = CIN(IN_LN2B) + l * D;
      const float* md_all = WSP(float, WS_MOD) + (size_t)l * 3 * 12288; const float* mdn_all = WSP(float, WS_MOD) + (size_t)(l + 1) * 3 * 12288;
      for (int i = t; i < 11 * (D / 4); i += NTHREADS) { const int v = i / (D / 4), k = (i % (D / 4)) * 4; f32x4 x;
          if (v == 0) x = *(const f32x4*)(lg + k); else if (v == 1) x = *(const f32x4*)(lb + k);
          else { const int sset = (v - 2) / 3, q = (v - 2) % 3;
              if (q == 0) x = *(const f32x4*)(md_all + (size_t)sset * 12288 + 5 * 2048 + k);
              else if (l + 1 < DEPTH) x = *(const f32x4*)(mdn_all + (size_t)sset * 12288 + (q == 1 ? 2048 : 0) + k);
              else x = (f32x4){0.f, 0.f, 0.f, 0.f}; }
          *(f32x4*)(PV + v * D + k) = x; } }
    __syncthreads();
    const int lane = opaque_tid() & 63;
    const int gw = C.blk * NWAVES + __builtin_amdgcn_readfirstlane(opaque_tid() >> 6), NGW = C.G * NWAVES;
    int n = gw;
    Ln2Raw cur; if (n < rows_total) ln2_load(C, tpg, n, lane, cur);
    for (; n < rows_total; n += NGW) {
        Ln2Raw nxt = cur; if (n + NGW < rows_total) ln2_load(C, tpg, n + NGW, lane, nxt);
        const float* pm = PV + (2 + 3 * mod_set(n)) * D;
        f32x4 v[8]; float s = 0.f;
#pragma unroll
        for (int j = 0; j < 8; ++j) { const int k = 4 * lane + 256 * j;
            const u32x2 a = cur.fa[j], bq = cur.fb[j]; const f32x4 g5 = *(const f32x4*)(pm + k);
            const f32x4 f = {bflo(a.x) + bflo(bq.x), bfhi(a.x) + bfhi(bq.x), bflo(a.y) + bflo(bq.y), bfhi(a.y) + bfhi(bq.y)};
            v[j] = cur.x[j] * ALPHA + g5 * f; s += (v[j][0] + v[j][1]) + (v[j][2] + v[j][3]); }
        const float mean = wave_sum(s) * (1.f / D); float s2 = 0.f;
#pragma unroll
        for (int j = 0; j < 8; ++j) { v[j] = v[j] - mean; s2 += (v[j][0] * v[j][0] + v[j][1] * v[j][1]) + (v[j][2] * v[j][2] + v[j][3] * v[j][3]); }
        const float rstd = rsqrtf(wave_sum(s2) * (1.f / D) + LN_EPS);
#pragma unroll
        for (int j = 0; j < 8; ++j) { const int k = 4 * lane + 256 * j;
            const f32x4 x2 = v[j] * rstd * *(const f32x4*)(PV + k) + *(const f32x4*)(PV + D + k);
            if (l == DEPTH - 1) __builtin_nontemporal_store(x2, (f32x4*)(C.out + (size_t)n * D + k));
            else { __builtin_nontemporal_store(x2, (f32x4*)(WSP(float, WS_XRES) + (size_t)n * D + k));
                const f32x4 hh = x2 * (*(const f32x4*)(pm + D + k) + 1.f) + *(const f32x4*)(pm + 2 * D + k);
                u32x2 w; w.x = cvtpk(hh[0], hh[1]); w.y = cvtpk(hh[2], hh[3]);
                __builtin_nontemporal_store(w, (u32x2*)(WSP(bf16, WS_HB) + (size_t)n * D + k)); } }
        cur = nxt;
    }
    __syncthreads();
}

#ifdef PROBE_ATTCHK
__device__ __forceinline__ void att_check(const Ctx& C, char* lds, int mla) {
    PHASE_IDS();
    float* sc = (float*)lds;
    float* red = sc + 8448;
    float* qv = red + 512;
    const int nh = mla ? 4 : 8, dq = mla ? 192 : 128;
    const int h = C.blk % nh, n = (C.blk * 67 + 13) % NL, b = n >> 13;
    const bf16* q = mla ? (WSP(bf16, WS_QM) + (size_t)n * 768 + h * 192) : (WSP(bf16, WS_QG) + (size_t)n * 1024 + h * 128);
    const bf16* K = mla ? (WSP(bf16, WS_KM) + (size_t)(b * 4 + h) * SKV * 192) : (WSP(bf16, WS_KG) + (size_t)(b * 2 + (h >> 2)) * SKV * 128);
    const bf16* V = mla ? (WSP(bf16, WS_VM) + (size_t)(b * 4 + h) * SKV * 128) : (WSP(bf16, WS_VG) + (size_t)(b * 2 + (h >> 2)) * SKV * 128);
    if (tid < dq) qv[tid] = bf2f(q[tid]);
    __syncthreads();
    const float scale = 0.6931471805599453f;
    float mx = -3e38f;
    for (int j = tid; j < SKV; j += NTHREADS) { float a = 0.f; for (int d = 0; d < dq; ++d) a += qv[d] * bf2f(K[(size_t)j * dq + d]); a *= scale; sc[j] = a; mx = fmaxf(mx, a); }
    red[tid] = mx; __syncthreads();
    for (int o = 256; o > 0; o >>= 1) { if (tid < o) red[tid] = fmaxf(red[tid], red[tid + o]); __syncthreads(); }
    mx = red[0]; __syncthreads();
    float sm = 0.f;
    for (int j = tid; j < SKV; j += NTHREADS) { const float p = __expf(sc[j] - mx); sc[j] = p; sm += p; }
    red[tid] = sm; __syncthreads();
    for (int o = 256; o > 0; o >>= 1) { if (tid < o) red[tid] += red[tid + o]; __syncthreads(); }
    sm = red[0]; __syncthreads();
    const int d = tid & 127, part = tid >> 7; float a = 0.f;
    for (int j = part; j < SKV; j += 4) a += sc[j] * bf2f(V[(size_t)j * 128 + d]);
    red[tid] = a; __syncthreads();
    float ref = 0.f, got = 0.f;
    if (tid < 128) { ref = (red[tid] + red[tid + 128] + red[tid + 256] + red[tid + 384]) / sm;
        got = bf2f(WSP(bf16, WS_MIX)[(size_t)n * D + (mla ? 1536 : 512) + h * 128 + tid]); }
    __syncthreads();
    red[tid] = (tid < 128) ? fabsf(ref) : 0.f; __syncthreads();
    for (int o = 256; o > 0; o >>= 1) { if (tid < o) red[tid] = fmaxf(red[tid], red[tid + o]); __syncthreads(); }
    const float rmax = red[0]; __syncthreads();
    red[tid] = (tid < 128) ? fabsf(ref - got) : 0.f; __syncthreads();
    for (int o = 256; o > 0; o >>= 1) { if (tid < o) red[tid] = fmaxf(red[tid], red[tid + o]); __syncthreads(); }
    if (tid == 0) { const float e = red[0] / fmaxf(rmax, 1e-20f); atomicMax((unsigned*)(C.ws + WS_CTL) + CW_CHK, __float_as_uint(e)); }
    __syncthreads();
}
#endif

#ifdef PROBE_PREPCHK
__device__ __forceinline__ float prep_rope_ang(int i, int nf, int prow, int pcol) { const int f = i < nf ? i : i - nf; const float inv = powf(10000.f, -(float)f / (float)nf); return (float)(i < nf ? prow : pcol) * inv; }
__device__ __forceinline__ void prep_check(const Ctx& C, char* lds, int l) {
    PHASE_IDS();
    float* hv = (float*)lds;
    float* zv = hv + 2048;
    float* tv = zv + 1024;
    float* red = tv + 1024;
    const int kind = C.blk & 3, sel = C.blk >> 2;
    const int n = (C.blk & 4) ? (NL + (C.blk * 37) % NC) : ((C.blk * 67 + 13) % NL);
    const bool lat = n < NL; int b, pos, prow = 0, pcol = 0;
    if (lat) { b = n >> 13; const int t = n & (T - 1); pos = CTXL + t; prow = t >> 6; pcol = t & 63; } else { b = (n - NL) >> 8; pos = (n - NL) & 255; }
    for (int k = tid; k < D; k += NTHREADS) hv[k] = bf2f(WSP(bf16, WS_HB)[(size_t)n * D + k]);
    __syncthreads();
    const float* win = CIN(IN_WIN) + (size_t)l * D * INW;
    const int hq = sel & 7, kvh = sel & 1, hm = sel & 3;
    const int ncol = kind == 0 ? 128 : kind == 1 ? 256 : kind == 2 ? 512 : 320;
    for (int c = tid; c < ncol; c += NTHREADS) {
        int oc;
        if (kind == 0) oc = 1552 + hq * 128 + c; else if (kind == 1) oc = (c < 128) ? (1552 + 1024 + kvh * 128 + c) : (1552 + 1280 + kvh * 128 + (c - 128));
        else if (kind == 2) oc = 3088 + c; else oc = 3088 + 512 + c;
        float a = 0.f; for (int k = 0; k < D; ++k) a += hv[k] * win[(size_t)k * INW + oc];
        zv[c] = a; }
    __syncthreads();
    float err = 0.f, vmax = 0.f;
    auto blockmax = [&](float v) { red[tid] = v; __syncthreads(); for (int o = 256; o > 0; o >>= 1) { if (tid < o) red[tid] = fmaxf(red[tid], red[tid + o]); __syncthreads(); } const float r = red[0]; __syncthreads(); return r; };
    auto blocksum = [&](float v) { red[tid] = v; __syncthreads(); for (int o = 256; o > 0; o >>= 1) { if (tid < o) red[tid] += red[tid + o]; __syncthreads(); } const float r = red[0]; __syncthreads(); return r; };
    if (kind == 0 || kind == 1) {
        const float* g = (kind == 0) ? CIN(IN_BQN) + l * 128 : CIN(IN_BKN) + l * 128;
        const float ss = blocksum(tid < 128 ? zv[tid] * zv[tid] : 0.f);
        const float rinv = rsqrtf(ss / 128.f + RMS_EPS);
        if (tid < 128) tv[tid] = zv[tid] * rinv * g[tid];
        __syncthreads();
        float ref = 0.f, got = 0.f;
        if (tid < 128) { const int i = tid & 63; const float ang = prep_rope_ang(i, 32, prow, pcol), cs = cosf(ang), sn = sinf(ang);
            ref = lat ? ((tid < 64) ? tv[i] * cs - tv[i + 64] * sn : tv[i + 64] * cs + tv[i] * sn) : tv[tid];
            if (kind == 0) { ref *= 0.12751743f; got = bf2f(WSP(bf16, WS_QG)[(size_t)n * 1024 + hq * 128 + tid]); }
            else got = bf2f(WSP(bf16, WS_KG)[((size_t)(b * 2 + kvh) * SKV + pos) * 128 + tid]); }
        else if (kind == 1 && tid < 256) { ref = zv[tid]; got = bf2f(WSP(bf16, WS_VG)[((size_t)(b * 2 + kvh) * SKV + pos) * 128 + (tid - 128)]); }
        vmax = blockmax(fabsf(ref)); err = blockmax(fabsf(ref - got)) / fmaxf(vmax, 1e-20f);
    } else if (kind == 2) {
        const float ss = blocksum(zv[tid] * zv[tid]);
        const float rinv = rsqrtf(ss / 512.f + RMS_EPS);
        tv[tid] = zv[tid] * rinv * CIN(IN_CQN)[l * 512 + tid];
        __syncthreads();
        const float* wuq = CIN(IN_WUQ) + (size_t)l * 512 * 768;
        if (tid < 192) { float a = 0.f; for (int k = 0; k < 512; ++k) a += tv[k] * wuq[(size_t)k * 768 + hm * 192 + tid]; zv[tid] = a; }
        __syncthreads();
        float ref = 0.f, got = 0.f;
        if (tid < 192) { if (tid < 128) ref = zv[tid]; else { const int j = tid - 128, i = j & 31; const float ang = prep_rope_ang(i, 16, prow, pcol), cs = cosf(ang), sn = sinf(ang);
                ref = lat ? ((j < 32) ? zv[128 + i] * cs - zv[128 + i + 32] * sn : zv[128 + i + 32] * cs + zv[128 + i] * sn) : zv[tid]; }
            ref *= MLA_QS; got = bf2f(WSP(bf16, WS_QM)[(size_t)n * 768 + hm * 192 + tid]); }
        vmax = blockmax(fabsf(ref)); err = blockmax(fabsf(ref - got)) / fmaxf(vmax, 1e-20f);
    } else {
        const float ss = blocksum(tid < 256 ? zv[tid] * zv[tid] : 0.f);
        const float rinv = rsqrtf(ss / 256.f + RMS_EPS);
        if (tid < 256) tv[tid] = zv[tid] * rinv * CIN(IN_CKVN)[l * 256 + tid];
        __syncthreads();
        const float* wukv = CIN(IN_WUKV) + (size_t)l * 256 * 1024;
        float kvv = 0.f;
        if (tid < 256) { for (int k = 0; k < 256; ++k) kvv += tv[k] * wukv[(size_t)k * 1024 + hm * 256 + tid]; }
        float ref = 0.f, got = 0.f;
        if (tid < 128) { ref = kvv; got = bf2f(WSP(bf16, WS_KM)[((size_t)(b * 4 + hm) * SKV + pos) * 192 + tid]); }
        else if (tid < 256) { ref = kvv; got = bf2f(WSP(bf16, WS_VM)[((size_t)(b * 4 + hm) * SKV + pos) * 128 + (tid - 128)]); }
        else if (tid < 320) { const int j = tid - 256, i = j & 31; const float ang = prep_rope_ang(i, 16, prow, pcol), cs = cosf(ang), sn = sinf(ang);
            ref = lat ? ((j < 32) ? zv[256 + i] * cs - zv[256 + i + 32] * sn : zv[256 + i + 32] * cs + zv[256 + i] * sn) : zv[tid];
            got = bf2f(WSP(bf16, WS_KM)[((size_t)(b * 4 + hm) * SKV + pos) * 192 + 128 + j]); }
        vmax = blockmax(fabsf(ref)); err = blockmax(fabsf(ref - got)) / fmaxf(vmax, 1e-20f);
    }
    if (tid == 0) atomicMax((unsigned*)(C.ws + WS_CTL) + CW_CHK, __float_as_uint(err));
    __syncthreads();
}
#endif
struct Args { const float* in[29]; float* out; unsigned char* ws; int ph_lo, ph_hi; };
constexpr int NPHASE = 2 + 9 * DEPTH;

__global__ void __launch_bounds__(NTHREADS, 2) trunk_fwd(Args args) {
    extern __shared__ __attribute__((aligned(16))) unsigned char lds[];
    Ctx C;
    C.out = args.out; C.ws = args.ws; C.G = gridDim.x; C.blk = blockIdx.x;
    char* ldsg = (char*)lds;
    LAS unsigned char* ldsl = (LAS unsigned char*)lds;
    if (threadIdx.x < 64) ((LAS unsigned*)(ldsl + LDS_MISC))[threadIdx.x] = 0u;
    __syncthreads();
    unsigned* ctl = (unsigned*)(C.ws + WS_CTL);
    XcdBarrier bar; bar.bar = ctl + CW_BAR; bar.x = 0; bar.st = nullptr;
    const int lo = args.ph_lo, hi = args.ph_hi;
    if (hi - lo > 1) bar = xcd_barrier_post(ctl + CW_BAR, (volatile LAS unsigned*)(ldsl + LDS_MISC + 32));
#ifndef PHASE_MASK
#define PHASE_MASK 0x7ff
#endif
#define HASP(k) ((PHASE_MASK >> (k)) & 1)
#ifndef SUBMASK
#define SUBMASK 0xff
#endif
#ifdef PROBE_NOATT
#undef SUBMASK
#define SUBMASK 0x47
#endif
#define HASS(k) ((SUBMASK >> (k)) & 1)
#define IN(k) (lo <= (k) && (k) < hi)
#define SEAM(k) do { if (IN(k) && IN((k) + 1)) xcd_barrier(bar); } while (0)
    const int NGW = C.G * NWAVES;
#define GWID() (C.blk * NWAVES + __builtin_amdgcn_readfirstlane(opaque_tid() >> 6))
#define REPS(k) for (int rep_ = 0; rep_ < ((PROBE_REP == (k)) ? 2 : 1); ++rep_)
#define REPBAR(k) do { if (PROBE_REP == (k) && rep_ == 0 && hi - lo > 1) xcd_barrier(bar); } while (0)
#define SUBON(b) (rep_ == 0 || ((PROBE_REPSUB >> (b)) & 1))

    if (HASP(0) && IN(0)) REPS(0) { phase_pre0(C, ldsg); REPBAR(0); } SEAM(0);
    if (HASP(1) && IN(1)) REPS(1) { phase_pre1(C); REPBAR(1); } SEAM(1);
#pragma nounroll
    for (int l = 0; l < DEPTH; ++l) {
        const int P = 2 + 9 * l;
        if (HASP(2) && IN(P + 0)) REPS(2) {
            if (C.G == 256) {
                pg8::DenseOrder S; S.init(M, 15 * 256, D, C.G, C.blk);
                EpiStore E{WSP(bf16, WS_Z), ZW};
                pg8::gemm_phase<EpiStore, pg8::DenseOrder>(ldsl, WSP(bf16, WS_HB), WSP(bf16, WS_WIN) + (size_t)l * ZW * D, D, S, E);
                pg8::TailOrder S2{C.blk, 222, 34, 15, M / 256, D};
                EpiStoreHalf E2{WSP(bf16, WS_Z), ZW};
                pg8::gemm_phase<EpiStoreHalf, pg8::TailOrder, 1>(ldsl, WSP(bf16, WS_HB), WSP(bf16, WS_WIN) + (size_t)l * ZW * D, D, S2, E2);
            } else {
                pg8::DenseOrder S; S.init(M, ZW, D, C.G, C.blk);
                EpiStore E{WSP(bf16, WS_Z), ZW};
                pg8::gemm_phase<EpiStore, pg8::DenseOrder>(ldsl, WSP(bf16, WS_HB), WSP(bf16, WS_WIN) + (size_t)l * ZW * D, D, S, E);
            }
            REPBAR(2);
        } SEAM(P + 0);
        if (HASP(3) && IN(P + 1)) REPS(3) {
            if (SUBON(0)) post_rows(C, l);
            if (SUBON(1)) for (int u = C.blk; u < 2 * 4 * NCHUNK; u += C.G) mlstm_a_unit(C, l, u, ldsg);
            REPBAR(3);
        } SEAM(P + 1);
        if (HASP(4) && IN(P + 2)) REPS(4) {
            const bool win = (C.G == 256);
            if (HASS(0) && SUBON(0)) { if (win) mlstm_scan_window(C, 222, 34); else mlstm_scan(C); }
            if (HASS(1) && SUBON(1)) { pg8::DenseOrder S; if (win) S.init_window(M, 768, 512, C.blk, 222); else S.init(M, 768, 512, C.G, C.blk);
              EpiQmla E{WSP(bf16, WS_QM), WSP(float, WS_ROPE) + 12288};
              pg8::gemm_phase<EpiQmla, pg8::DenseOrder>(ldsl, WSP(bf16, WS_CQ), WSP(bf16, WS_WUQ) + (size_t)l * 768 * 512, 512, S, E); }
            if (HASS(2) && SUBON(2)) { pg8::DenseOrder S; if (win) S.init_window(M, 1024, 256, C.blk, 222); else S.init(M, 1024, 256, C.G, C.blk);
              EpiKVmla E{WSP(bf16, WS_KM), WSP(bf16, WS_VM)};
              pg8::gemm_phase<EpiKVmla, pg8::DenseOrder>(ldsl, WSP(bf16, WS_CKV), WSP(bf16, WS_WUKV) + (size_t)l * 1024 * 256, 256, S, E); }
            REPBAR(4);
        } SEAM(P + 2);
        if (HASP(5) && IN(P + 3)) REPS(5) {
#ifdef PROBE_NOATT
            { PHASE_IDS(); const int rows_t = (l == 0) ? M : NL;
              for (int n = C.blk * NWAVES + wave; n < rows_t; n += NGW) { bf16* mr = WSP(bf16, WS_MIX) + (size_t)n * D + 512;
                  for (int j = 0; j < 3; ++j) *(u32x4*)(mr + (lane + 64 * j) * 8) = (u32x4){0u, 0u, 0u, 0u}; } }
#endif
            bool gqa_fixed;
            { const float* gq = CIN(IN_BQN) + l * 128; const float* gk = CIN(IN_BKN) + l * 128; const int ln_ = opaque_tid() & 63;
              float mq = fmaxf(fabsf(gq[ln_]), fabsf(gq[64 + ln_])), mk = fmaxf(fabsf(gk[ln_]), fabsf(gk[64 + ln_]));
#define AMAX_STEP(MSK_) do { mq = fmaxf(mq, __int_as_float(__builtin_amdgcn_ds_swizzle(__float_as_int(mq), ((MSK_) << 10) | 0x1F))); mk = fmaxf(mk, __int_as_float(__builtin_amdgcn_ds_swizzle(__float_as_int(mk), ((MSK_) << 10) | 0x1F))); } while (0)
              AMAX_STEP(1); AMAX_STEP(2); AMAX_STEP(4); AMAX_STEP(8); AMAX_STEP(16);
#undef AMAX_STEP
              { auto rq = __builtin_amdgcn_permlane32_swap(__float_as_uint(mq), __float_as_uint(mq), false, false); mq = fmaxf(__uint_as_float(rq[0]), __uint_as_float(rq[1]));
                auto rk = __builtin_amdgcn_permlane32_swap(__float_as_uint(mk), __float_as_uint(mk), false, false); mk = fmaxf(__uint_as_float(rk[0]), __uint_as_float(rk[1])); }
              gqa_fixed = __builtin_amdgcn_readfirstlane((int)(11.313708f * 1.4426950f * mq * mk < 60.f)) != 0; }
            const int fslot = (C.blk >> 3) & 3, fb0 = (l == 0 && C.G == 256) ? 16 : 0, fnb = (l == 0 && C.G == 256) ? 216 : C.G;
#define FILL_AT(s_) do { if (SUBON(0) && fslot == (s_) && C.blk >= fb0 && C.blk < fb0 + fnb) { __syncthreads(); fill_finish(C, ldsg, l, fb0, fnb); __syncthreads(); } } while (0)
            FILL_AT(0);
            if (HASS(3) && SUBON(0)) for (int u0 = C.blk; u0 < 2 * 4 * 32; u0 += C.G) { const int u = (C.G == 256) ? ((u0 & 7) * 32 + (u0 >> 3)) : u0;
                const int qb = u & 31, h = (u >> 5) & 3, b = u >> 7;
                if (!att::attn_body<192, 768, 192, D, 1, 2, 2>(WSP(bf16, WS_QM) + ((size_t)(b * T + qb * 256)) * 768 + h * 192, WSP(bf16, WS_KM) + (size_t)(b * 4 + h) * SKV * 192,
                    WSP(bf16, WS_VM) + (size_t)(b * 4 + h) * SKV * 128, WSP(bf16, WS_MIX) + ((size_t)(b * T + qb * 256)) * D + 1536 + h * 128, SKV, ldsg))
                    att::attn_body<192, 768, 192, D, 1, 1>(WSP(bf16, WS_QM) + ((size_t)(b * T + qb * 256)) * 768 + h * 192, WSP(bf16, WS_KM) + (size_t)(b * 4 + h) * SKV * 192,
                        WSP(bf16, WS_VM) + (size_t)(b * 4 + h) * SKV * 128, WSP(bf16, WS_MIX) + ((size_t)(b * T + qb * 256)) * D + 1536 + h * 128, SKV, ldsg); }
            FILL_AT(1);
            if (HASS(4) && SUBON(1)) for (int u0 = C.blk; u0 < 2 * 8 * 32; u0 += C.G) { int u = u0;
                if (C.G == 256) { const int c = u0 & 255, rnd = u0 >> 8, x = c & 7, pr = x >> 1, il = (c >> 3) * 2 + (x & 1) + 64 * rnd; u = pr * 128 + il; }
                const int qb = u & 31, h = (u >> 5) & 7, b = u >> 8;
                if (gqa_fixed) att::attn_body<128, 1024, 128, D, 1, 2, 7>(WSP(bf16, WS_QG) + ((size_t)(b * T + qb * 256)) * 1024 + h * 128, WSP(bf16, WS_KG) + (size_t)(b * 2 + (h >> 2)) * SKV * 128,
                    WSP(bf16, WS_VG) + (size_t)(b * 2 + (h >> 2)) * SKV * 128, WSP(bf16, WS_MIX) + ((size_t)(b * T + qb * 256)) * D + 512 + h * 128, SKV, ldsg);
                else att::attn_body<128, 1024, 128, D, 2, 1>(WSP(bf16, WS_QG) + ((size_t)(b * T + qb * 256)) * 1024 + h * 128, WSP(bf16, WS_KG) + (size_t)(b * 2 + (h >> 2)) * SKV * 128,
                    WSP(bf16, WS_VG) + (size_t)(b * 2 + (h >> 2)) * SKV * 128, WSP(bf16, WS_MIX) + ((size_t)(b * T + qb * 256)) * D + 512 + h * 128, SKV, ldsg); }
            FILL_AT(2);
            if (HASS(5) && SUBON(2) && l < DEPTH - 1) {
                for (int u = C.G - 1 - C.blk; u < 2 * 4; u += C.G) { const int h = u & 3, b = u >> 2;
                    att::attn_body<192, 768, 192, D, 1, 1>(WSP(bf16, WS_QM) + ((size_t)(NL + b * CTXL)) * 768 + h * 192, WSP(bf16, WS_KM) + (size_t)(b * 4 + h) * SKV * 192,
                        WSP(bf16, WS_VM) + (size_t)(b * 4 + h) * SKV * 128, WSP(bf16, WS_MIX) + ((size_t)(NL + b * CTXL)) * D + 1536 + h * 128, CTXL, ldsg); }
                for (int u = C.G - 9 - C.blk; u < 2 * 8; u += C.G) { if (u < 0) continue; const int h = u & 7, b = u >> 3;
                    att::attn_body<128, 1024, 128, D, 2, 1>(WSP(bf16, WS_QG) + ((size_t)(NL + b * CTXL)) * 1024 + h * 128, WSP(bf16, WS_KG) + (size_t)(b * 2 + (h >> 2)) * SKV * 128,
                        WSP(bf16, WS_VG) + (size_t)(b * 2 + (h >> 2)) * SKV * 128, WSP(bf16, WS_MIX) + ((size_t)(NL + b * CTXL)) * D + 512 + h * 128, CTXL, ldsg); }
            }
            if (HASS(6) && SUBON(3)) for (int u = C.blk; u < 2 * 4 * NCHUNK; u += C.G) { if (l == DEPTH - 1 && (u % NCHUNK) < 2) continue; mlstm_c_unit(C, l, u, ldsg); }
            FILL_AT(3);
#undef FILL_AT
            REPBAR(5);
        } SEAM(P + 3);
#ifdef PROBE_ATTCHK
        if (l == 0 && hi - lo > 1) { att_check(C, ldsg, PROBE_ATTCHK == 1); }
#endif
#ifdef PROBE_PREPCHK
        if (l == PROBE_PREPCHK - 1 && hi - lo > 1) { prep_check(C, ldsg, l); }
#endif
        if (HASP(6) && IN(P + 4)) REPS(6) {
            pg8::DenseOrder S; S.init((l == 0) ? M : NL, D, D, C.G, C.blk);
            EpiStore E{WSP(bf16, WS_Y), D};
            pg8::gemm_phase<EpiStore, pg8::DenseOrder>(ldsl, WSP(bf16, WS_MIX), WSP(bf16, WS_WOUT) + (size_t)l * D * D, D, S, E);
            REPBAR(6);
        } SEAM(P + 4);
        if (HASP(7) && IN(P + 5)) { phase_ln1(C, l, ldsg); } SEAM(P + 5);
        if (HASP(8) && IN(P + 6)) REPS(8) {
            moe_tables(C, l, ldsg);
            MoeOrder1 S{C.G, C.blk, (const LAS int*)(ldsl + LDS_MISC + 64), (const LAS int*)(ldsl + LDS_MISC + 136), WSP(int, WS_LIST), (C.G == 256) ? 2 : (1 << 30)};
            EpiGLU E{WSP(bf16, WS_HID), WSP(float, WS_ROWW), (const LAS int*)(ldsl + LDS_MISC + 136)};
            pg8::gemm_phase<EpiGLU, MoeOrder1>(ldsl, WSP(bf16, WS_HB), wgu_base(C, l), D, S, E);
            if (C.G == 256) {
                MoeOrder1Tail S2{C.G, C.blk, (const LAS int*)(ldsl + LDS_MISC + 64), (const LAS int*)(ldsl + LDS_MISC + 136), WSP(int, WS_LIST)};
                EpiGLUHalf E2{WSP(bf16, WS_HID), WSP(float, WS_ROWW), (const LAS int*)(ldsl + LDS_MISC + 136)};
                pg8::gemm_phase<EpiGLUHalf, MoeOrder1Tail, 2>(ldsl, WSP(bf16, WS_HB), wgu_base(C, l), D, S2, E2);
            }
            REPBAR(8);
        } SEAM(P + 6);
        if (HASP(9) && IN(P + 7)) REPS(9) {
            moe_tables(C, l, ldsg);
            MoeOrder2 S{C.G, C.blk, (const LAS int*)(ldsl + LDS_MISC + 64), (C.G == 256) ? 4 : (1 << 30)};
            EpiStore E{WSP(bf16, WS_FSLOT), D};
            pg8::gemm_phase<EpiStore, MoeOrder2>(ldsl, WSP(bf16, WS_HID), wd_base(C, l), DEXP, S, E);
            if (C.G == 256) {
                MoeOrder2Tail S2{C.G, C.blk, (const LAS int*)(ldsl + LDS_MISC + 64)};
                EpiStoreHalfM E2{WSP(bf16, WS_FSLOT), D};
                pg8::gemm_phase<EpiStoreHalfM, MoeOrder2Tail, 2>(ldsl, WSP(bf16, WS_HID), wd_base(C, l), DEXP, S2, E2);
            }
            REPBAR(9);
        } SEAM(P + 7);
        if (HASP(10) && IN(P + 8)) { moe_tables(C, l, ldsg); phase_ln2(C, l, ldsg); } SEAM(P + 8);
    }
#if defined(PROBE_ATTCHK) || defined(PROBE_PREPCHK)
    if (hi - lo > 1) { xcd_barrier(bar);
        if (C.blk == 0 && threadIdx.x == 0) { const float e = __uint_as_float(__hip_atomic_load((unsigned*)(C.ws + WS_CTL) + CW_CHK, __ATOMIC_RELAXED, __HIP_MEMORY_SCOPE_AGENT));
            C.out[0] += sqrtf(fminf(e, 10.f) * 1e-2f * (float)(NL) * (float)D); } }
#endif
#undef IN
#undef SEAM
}

extern "C" void kernel_launch(void* const* d_in, const int* in_sizes, int n_in, void* d_out, int out_size, void* d_ws, size_t ws_size, hipStream_t stream) {
    static int grid = 0;
    if (grid == 0) {
        if (n_in != 29 || in_sizes[0] != NL * D || out_size != NL * D || ws_size < WS_END) {
            fprintf(stderr, "kernel_launch: shape mismatch: n_in %d in0 %d out %d ws %zu (need %zu)\n", n_in, n_in > 0 ? in_sizes[0] : -1, out_size, ws_size, (size_t)WS_END); grid = -1; return; }
        int dev = 0, cus = 0, per_cu = 0;
        if (hipGetDevice(&dev) != hipSuccess || hipDeviceGetAttribute(&cus, hipDeviceAttributeMultiprocessorCount, dev) != hipSuccess) { grid = -1; return; }
        if (hipFuncSetAttribute((const void*)trunk_fwd, hipFuncAttributeMaxDynamicSharedMemorySize, LDS_BYTES) != hipSuccess) { fprintf(stderr, "kernel_launch: hipFuncSetAttribute failed\n"); grid = -1; return; }
        if (hipOccupancyMaxActiveBlocksPerMultiprocessor(&per_cu, (const void*)trunk_fwd, NTHREADS, LDS_BYTES) != hipSuccess || per_cu < 1) { fprintf(stderr, "kernel_launch: occupancy query reports %d\n", per_cu); }
        (void)hipGetLastError();
        grid = cus;
        if (grid < 235) { fprintf(stderr, "kernel_launch: %d CUs; the LN1 phase is laid out for >= 235 workgroups (<= 72 rows each)\n", grid); grid = -1; return; }
    }
    if (grid < 0) return;
    (void)hipMemsetAsync((char*)d_ws + WS_CTL, 0, CTL_BYTES, stream);
    Args a{};
    for (int i = 0; i < 29; ++i) a.in[i] = (const float*)d_in[i];
    a.out = (float*)d_out; a.ws = (unsigned char*)d_ws;
#if MK_N_LAUNCHES == 1
    a.ph_lo = 0; a.ph_hi = NPHASE;
    hipLaunchKernelGGL(trunk_fwd, dim3(grid), dim3(NTHREADS), LDS_BYTES, stream, a);
#else
    for (int p = 0; p < NPHASE; ++p) { a.ph_lo = p; a.ph_hi = p + 1; hipLaunchKernelGGL(trunk_fwd, dim3(grid), dim3(NTHREADS), LDS_BYTES, stream, a); }
#endif
    const hipError_t le = hipPeekAtLastError();
    if (le != hipSuccess) fprintf(stderr, "kernel_launch: launch failed: %s\n", hipGetErrorName(le));
}
```

```cpp
#ifndef PROBE_REP
#define PROBE_REP -1
#endif
#ifndef PROBE_REPSUB
#define PROBE_REPSUB 0xff
#endif
#include <hip/hip_runtime.h>
#include <cstdio>
#include <cstdint>

#ifndef MK_N_LAUNCHES
#define MK_N_LAUNCHES 1
#endif

constexpr int D = 2048, NBATCH = 2, T = 8192, CTXL = 256, DEPTH = 2;
constexpr int NL = NBATCH * T;
constexpr int NC = NBATCH * CTXL;
constexpr int M = NL + NC;
constexpr int SKV = CTXL + T;
constexpr int INW = 3920, ZW = 4096;
constexpr int ZQG = 0, ZKG = 1024, ZVG = 1280, ZCQ = 1536, ZCKV = 2048, ZKR = 2304, ZGATE = 2368, ZMQ = 2384, ZMK = 2640, ZMV = 2896, ZOG = 3408;
constexpr int NEXP = 16, DEXP = 512;
constexpr int NCHUNK = 66;
constexpr float LN_EPS = 1e-6f, RMS_EPS = 1e-6f;
constexpr float ALPHA = 1.4142135623730951f;
constexpr int MAXSLOT = 37888;

constexpr size_t al256(size_t x) { return (x + 255) / 256 * 256; }
constexpr size_t WS_CTL = 0, CTL_BYTES = 1u << 20;
constexpr size_t WS_MOD = WS_CTL + CTL_BYTES;
constexpr size_t WS_ROPE = WS_MOD + al256((size_t)2 * 3 * 12288 * 4);
constexpr size_t WS_WIN = WS_ROPE + al256((size_t)18432 * 4);
constexpr size_t WS_WOUT = WS_WIN + (size_t)2 * ZW * D * 2;
constexpr size_t WS_WUQ = WS_WOUT + (size_t)2 * D * D * 2;
constexpr size_t WS_WUKV = WS_WUQ + (size_t)2 * 768 * 512 * 2;
constexpr size_t WS_WGU = WS_WUKV + (size_t)2 * 1024 * 256 * 2;
constexpr size_t WS_WD = WS_WGU + (size_t)NEXP * 1024 * D * 2;
constexpr size_t WS_HB = WS_WD + (size_t)NEXP * D * DEXP * 2;
constexpr size_t WS_Z = WS_HB + (size_t)M * D * 2;
constexpr size_t WS_QG = WS_Z + (size_t)M * ZW * 2;
constexpr size_t WS_KG = WS_QG + (size_t)M * 1024 * 2;
constexpr size_t WS_VG = WS_KG + (size_t)2 * 2 * SKV * 128 * 2;
constexpr size_t WS_CQ = WS_VG + (size_t)2 * 2 * SKV * 128 * 2;
constexpr size_t WS_CKV = WS_CQ + (size_t)M * 512 * 2;
constexpr size_t WS_QM = WS_CKV + (size_t)M * 256 * 2;
constexpr size_t WS_KM = WS_QM + (size_t)M * 768 * 2;
constexpr size_t WS_VM = WS_KM + (size_t)2 * 4 * SKV * 192 * 2;
constexpr size_t WS_U = WS_VM + (size_t)2 * 4 * SKV * 128 * 2;
constexpr size_t WS_UN = WS_U + (size_t)16 * NCHUNK * 8192 * 4;
constexpr size_t WS_USTAT = WS_UN + (size_t)16 * NCHUNK * 64 * 4;
constexpr size_t WS_CST = WS_USTAT + al256((size_t)16 * NCHUNK * 2 * 4);
constexpr size_t WS_NST = WS_CST + (size_t)16 * NCHUNK * 8192 * 2;
constexpr size_t WS_MST = WS_NST + (size_t)16 * NCHUNK * 64 * 4;
constexpr size_t WS_MIX = WS_MST + al256((size_t)16 * NCHUNK * 4);
constexpr size_t WS_XRES = WS_MIX + (size_t)M * D * 2;
constexpr size_t WS_LIST = WS_XRES + (size_t)M * D * 4;
constexpr size_t WS_ROWW = WS_LIST + (size_t)NEXP * M * 4;
constexpr size_t WS_TSLOT = WS_ROWW + (size_t)NEXP * M * 4;
constexpr size_t WS_WRT = WS_TSLOT + (size_t)M * 2 * 4;
constexpr size_t WS_END = WS_WRT + (size_t)2 * 2 * 32 * D * 2;
constexpr size_t WS_Y = WS_Z;
constexpr size_t WS_FSLOT = WS_Z;
constexpr size_t WS_HID = WS_MIX;
static_assert((size_t)MAXSLOT * D * 2 <= (size_t)M * ZW * 2 + (size_t)M * 1024 * 2, "fslot alias");
static_assert((size_t)MAXSLOT * DEXP * 2 <= (size_t)M * D * 2, "hid alias");
constexpr int CW_BAR = 4096;
constexpr int CW_CNT = 8192;
constexpr int CW_CHK = 8192 + 64;
constexpr int CW_FILL = 8192 + 128;

constexpr int LDS_BYTES = 147456;
constexpr int LDS_MISC = 147456 - 256;
constexpr int NWAVES = 8, NTHREADS = 512;

#define GAS __attribute__((address_space(1)))
#define LAS __attribute__((address_space(3)))
typedef unsigned short bf16;
typedef short bf16x8 __attribute__((ext_vector_type(8)));
typedef short s16x4 __attribute__((ext_vector_type(4)));
typedef float f32x4 __attribute__((ext_vector_type(4)));
typedef float f32x2 __attribute__((ext_vector_type(2)));
typedef float f32x8 __attribute__((ext_vector_type(8)));
typedef float f32x16 __attribute__((ext_vector_type(16)));
typedef unsigned u32x4 __attribute__((ext_vector_type(4)));
typedef unsigned u32x2 __attribute__((ext_vector_type(2)));
#define LDS_WAIT() asm volatile("s_waitcnt lgkmcnt(0)" ::: "memory")
#define VM_WAIT() asm volatile("s_waitcnt vmcnt(0)" ::: "memory")
#define SBAR() __builtin_amdgcn_sched_barrier(0)
#define LDS_BARRIER() do { asm volatile("s_waitcnt lgkmcnt(0)" ::: "memory"); __builtin_amdgcn_s_barrier(); asm volatile("" ::: "memory"); } while (0)

__device__ __forceinline__ int opaque_tid() { int t = threadIdx.x; asm volatile("" : "+v"(t)); return t; }
__device__ __forceinline__ unsigned cvtpk(float lo, float hi) { unsigned r; asm volatile("v_cvt_pk_bf16_f32 %0, %1, %2" : "=v"(r) : "v"(lo), "v"(hi)); return r; }
__device__ __forceinline__ float bf2f(unsigned short b) { return __uint_as_float((unsigned)b << 16); }
__device__ __forceinline__ float bflo(unsigned w) { return __uint_as_float(w << 16); }
__device__ __forceinline__ float bfhi(unsigned w) { return __uint_as_float(w & 0xffff0000u); }
__device__ __forceinline__ bf16 f2bf(float f) { return (bf16)(cvtpk(f, 0.f) & 0xffffu); }
__device__ __forceinline__ float wave_sum(float v) {
#pragma unroll
    for (int o = 1; o < 64; o <<= 1) v += __shfl_xor(v, o);
    return v;
}
__device__ __forceinline__ float sigmoidf_(float x) { return 1.f / (1.f + __expf(-x)); }
__device__ __forceinline__ float siluf_(float x) { return x / (1.f + __expf(-x)); }
__device__ __forceinline__ float logsigmoidf_(float x) { return fminf(x, 0.f) - log1pf(__expf(-fabsf(x))); }

#define XB_TMO      128
#define XB_XCNT(j)  (256  + 64 * (j))
#define XB_XSUB(j)  (1280 + 64 * (j))
#define XB_XGEN(j)  (2304 + 64 * (j))
#define XB_TOP      3328
#define XB_TOPGEN   3392
#define XCD_BAR_WORDS 3456
#define XB_SPIN_CAP (1u << 18)
__device__ __forceinline__ unsigned xb_ld(unsigned* p)              { return __hip_atomic_load(p, __ATOMIC_RELAXED, __HIP_MEMORY_SCOPE_AGENT); }
__device__ __forceinline__ unsigned xb_add(unsigned* p, unsigned v) { return __hip_atomic_fetch_add(p, v, __ATOMIC_RELAXED, __HIP_MEMORY_SCOPE_AGENT); }
__device__ __forceinline__ unsigned xb_xcc_id() { return (unsigned)__builtin_amdgcn_s_getreg((3 << 11) | 20) & 0xFu; }
#define XB_SPIN(cond, bar) do { unsigned _sp = 0; while (cond) { __builtin_amdgcn_s_sleep(1); \
    if ((++_sp & 255u) == 0u) { if (xb_ld(&(bar)[XB_TMO])) break; if (_sp > XB_SPIN_CAP) { atomicAdd(&(bar)[XB_TMO], 1u); break; } } } } while (0)
struct XcdBarrier { unsigned* bar; unsigned x; volatile LAS unsigned* st; };
__device__ __forceinline__ XcdBarrier xcd_barrier_post(unsigned* bar, volatile LAS unsigned* st) {
    XcdBarrier b; b.bar = bar; b.x = xb_xcc_id(); b.st = st;
    if (threadIdx.x == 0) (void)xb_add(&bar[XB_XCNT(b.x)], 1u);
    return b;
}
__device__ __forceinline__ void xcd_barrier_complete(unsigned* bar, unsigned x, unsigned& nloc, unsigned& nx) {
    const unsigned G = gridDim.x * gridDim.y * gridDim.z;
    unsigned sum, cnt, mine, sp = 0u;
    for (;;) {
        sum = 0u; cnt = 0u; mine = 0u;
#pragma nounroll
        for (unsigned j = 0; j < 16; ++j) { const unsigned c = xb_ld(&bar[XB_XCNT(j)]); sum += c; cnt += (c > 0u) ? 1u : 0u; mine = (j == x) ? c : mine; }
        if (sum == G) break;
        __builtin_amdgcn_s_sleep(1);
        if ((++sp & 255u) == 0u) { if (xb_ld(&bar[XB_TMO])) break; if (sp > XB_SPIN_CAP) { atomicAdd(&bar[XB_TMO], 1u); break; } }
    }
    nloc = mine > 0u ? mine : 1u; nx = cnt > 0u ? cnt : 1u;
}
__device__ __forceinline__ void xcd_barrier(const XcdBarrier& b) {
    asm volatile("s_waitcnt vmcnt(0)" ::: "memory");
    __syncthreads();
    if (threadIdx.x == 0) {
        unsigned* bar = b.bar; unsigned bx = b.x;
        asm volatile("" : "+s"(bar), "+s"(bx));
        __builtin_amdgcn_s_waitcnt(0);
        unsigned nloc = b.st[0], nx = b.st[1];
        if (nloc == 0u) { xcd_barrier_complete(bar, bx, nloc, nx); b.st[0] = nloc; b.st[1] = nx; }
        const unsigned old = xb_add(&bar[XB_XSUB(bx)], 1u);
        const unsigned gen = old / nloc;
        if (old + 1u == (gen + 1u) * nloc) {
            __builtin_amdgcn_fence(__ATOMIC_RELEASE, "agent");
            asm volatile("s_waitcnt vmcnt(0)" ::: "memory");
            const unsigned og = xb_add(&bar[XB_TOP], 1u);
            const unsigned tg = og / nx;
            if (og + 1u == (tg + 1u) * nx) xb_add(&bar[XB_TOPGEN], 1u);
            else XB_SPIN(xb_ld(&bar[XB_TOPGEN]) == tg, bar);
            __builtin_amdgcn_fence(__ATOMIC_ACQUIRE, "agent");
            xb_add(&bar[XB_XGEN(bx)], 1u);
            asm volatile("s_waitcnt vmcnt(0)" ::: "memory");
        } else {
            XB_SPIN(xb_ld(&bar[XB_XGEN(bx)]) == gen, bar);
            __builtin_amdgcn_fence(__ATOMIC_ACQUIRE, "agent");
            asm volatile("s_waitcnt vmcnt(0)" ::: "memory");
        }
    }
    __syncthreads();
}

namespace pg8 {
constexpr int BM = 256, BK = 64, HALF = 128, HTB = HALF * BK * 2, STAGE_BYTES = 8 * HTB;
__host__ __device__ __forceinline__ int lds_byte(int r, int c) { const int st = (r >> 4) * 2 + (c >> 5), rr = r & 15, cc = c & 31, ob = rr * 64 + cc * 2; return st * 1024 + (ob ^ (((ob >> 9) & 1) << 5)); }
__host__ __device__ __forceinline__ void stage_rc(int b, int& R, int& C) { const int st = b / 1024, sb = b % 1024, swz = sb ^ (((sb >> 9) & 1) << 5); R = (st >> 1) * 16 + swz / 64; C = (st & 1) * 32 + (swz % 64) / 2; }
__host__ __device__ __forceinline__ int perm32(int rho) { const int n = rho >> 4, i = rho & 15; return 8 * (i >> 2) + 4 * n + (i & 3); }

struct Unit { int pm, pn, e, j, ne, hf; };

struct DenseOrder {
    static constexpr bool GATHER = false;
    int nM, nN, nwg, G, c, K;
    __device__ void init(int Mrows, int N, int K_, int G_, int c_) { nM = Mrows / BM; nN = N / BM; nwg = nM * nN; G = G_; c = c_; K = K_; }
    __device__ void init_window(int Mrows, int N, int K_, int blk, int nb) { nM = Mrows / BM; nN = N / BM; nwg = (blk < nb) ? nM * nN : 0; G = nb; c = blk; K = K_; }
    __device__ bool next(int i, Unit& u) const {
        const long L = (long)i * G + c; if (L >= nwg) return false;
        int wgid = (int)L; { const int q = nwg / 8, r = nwg % 8, xcd = wgid % 8, off = wgid / 8; wgid = (xcd < r ? xcd * (q + 1) : r * (q + 1) + (xcd - r) * q) + off; }
        const int nig = 8 * nN, gid = wgid / nig, fm = gid * 8, gsz = (nM - fm) < 8 ? (nM - fm) : 8;
        u.pm = fm + ((wgid % nig) % gsz); u.pn = (wgid % nig) / gsz; u.e = 0; u.j = 0; u.ne = 0; u.hf = 0; return true;
    }
    __device__ __forceinline__ unsigned a_row(const Unit& u, int r) const { return (unsigned)(u.pm * BM + r); }
    __device__ __forceinline__ size_t b_off(const Unit& u) const { return (size_t)u.pn * BM * K * 2; }
};

struct TailOrder {
    static constexpr bool GATHER = false;
    int c, first, nb, pn, nM, K;
    __device__ bool next(int i, Unit& u) const { const int j = c - first; if (j < 0 || j >= nb) return false; const int pm = j + nb * i; if (pm >= nM) return false;
        u.pm = pm; u.pn = pn; u.e = 0; u.j = 0; u.ne = 0; u.hf = 0; return true; }
    __device__ __forceinline__ unsigned a_row(const Unit& u, int r) const { return (unsigned)(u.pm * BM + r); }
    __device__ __forceinline__ size_t b_off(const Unit& u) const { return (size_t)u.pn * BM * K * 2; }
};

template <class Epi, class Sched, int VAR = 0>
__device__ __forceinline__ void gemm_phase(LAS unsigned char* lds, const bf16* A, const bf16* Bt, const int K, const Sched& S, const Epi& E) {
    const int tid = opaque_tid(), wid = __builtin_amdgcn_readfirstlane(tid >> 6), lane = tid & 63, wr = wid >> 2, wc = wid & 3, fr = lane & 15, fq = lane >> 4;
    const int nt = K / BK;
    unsigned voffB[2], voffA[2];
    { int R0, C0, R1, C1; stage_rc(tid * 16, R0, C0); stage_rc(tid * 16 + 8192, R1, C1);
      const int Rb0 = Epi::PERM ? ((R0 & ~31) + perm32(R0 & 31)) : R0, Rb1 = Epi::PERM ? ((R1 & ~31) + perm32(R1 & 31)) : R1;
      voffB[0] = (unsigned)(Rb0 * K + C0) * 2u; voffB[1] = (unsigned)(Rb1 * K + C1) * 2u;
      voffA[0] = (unsigned)(R0 * K + C0) * 2u; voffA[1] = (unsigned)(R1 * K + C1) * 2u; }
    const size_t kstep = (size_t)(BK * 2);
    const size_t hstep = (size_t)HALF * K * 2;
    const unsigned ldsw = (unsigned)wid * 1024u;
    const int aoff = lds_byte(wr * 64 + fr, fq * 8), boff = lds_byte(wc * 32 + fr, fq * 8);
#define PG8_SA(b, h) (((b) * 2 + (h)) * HTB)
#define PG8_SB(b, h) ((4 + (b) * 2 + (h)) * HTB)
#define PG8_STAGEB(bufoff, gbase) do { \
        __builtin_amdgcn_global_load_lds((const unsigned*)((const char*)(gbase) + voffB[0]), (LAS unsigned*)(lds + (bufoff) + ldsw), 16, 0, 0); \
        __builtin_amdgcn_global_load_lds((const unsigned*)((const char*)(gbase) + voffB[1]), (LAS unsigned*)(lds + (bufoff) + ldsw + 8192), 16, 0, 0); } while (0)
#define PG8_STAGEA(bufoff, h, kb) do { \
        if constexpr (Sched::GATHER) { \
            __builtin_amdgcn_global_load_lds((const unsigned*)((const char*)A + (kb) + ((h) ? g10 : g00)), (LAS unsigned*)(lds + (bufoff) + ldsw), 16, 0, 0); \
            __builtin_amdgcn_global_load_lds((const unsigned*)((const char*)A + (kb) + ((h) ? g11 : g01)), (LAS unsigned*)(lds + (bufoff) + ldsw + 8192), 16, 0, 0); \
        } else { \
            __builtin_amdgcn_global_load_lds((const unsigned*)(cA + (h) * hstep + (kb) + voffA[0]), (LAS unsigned*)(lds + (bufoff) + ldsw), 16, 0, 0); \
            __builtin_amdgcn_global_load_lds((const unsigned*)(cA + (h) * hstep + (kb) + voffA[1]), (LAS unsigned*)(lds + (bufoff) + ldsw + 8192), 16, 0, 0); } } while (0)
#define PG8_LDA(dst, b, h) do { _Pragma("unroll") for (int m = 0; m < 4; ++m) _Pragma("unroll") for (int k = 0; k < 2; ++k) dst[m][k] = *(const LAS bf16x8*)(lds + PG8_SA(b, h) + aoff + m * 2048 + k * 1024); } while (0)
#define PG8_LDB(dst, b, h) do { _Pragma("unroll") for (int n = 0; n < 2; ++n) _Pragma("unroll") for (int k = 0; k < 2; ++k) dst[n][k] = *(const LAS bf16x8*)(lds + PG8_SB(b, h) + boff + n * 2048 + k * 1024); } while (0)
#define PG8_MMA(ai, bj, At, Bt_) do { __builtin_amdgcn_s_setprio(1); _Pragma("unroll") for (int m = 0; m < 4; ++m) _Pragma("unroll") for (int n = 0; n < 2; ++n) _Pragma("unroll") for (int k = 0; k < 2; ++k) \
        acc[ai][bj][m][n] = __builtin_amdgcn_mfma_f32_16x16x32_bf16(Bt_[n][k], At[m][k], acc[ai][bj][m][n], 0, 0, 0); __builtin_amdgcn_s_setprio(0); } while (0)
#define PG8_WAIT_V(n) asm volatile("s_waitcnt vmcnt(" #n ")" ::: "memory")
#define PG8_WAIT_L(n) asm volatile("s_waitcnt lgkmcnt(" #n ")" ::: "memory")
#define PG8_BAR __builtin_amdgcn_s_barrier()
#define PG8_SCHED __builtin_amdgcn_sched_barrier(0)
#define PG8_GOFF(u) do { int R0_, C0_, R1_, C1_; stage_rc(tid * 16, R0_, C0_); stage_rc(tid * 16 + 8192, R1_, C1_); \
        g00 = (S.a_row(u, R0_) * (unsigned)K + (unsigned)C0_) * 2u; g01 = (S.a_row(u, R1_) * (unsigned)K + (unsigned)C1_) * 2u; \
        g10 = (S.a_row(u, HALF + R0_) * (unsigned)K + (unsigned)C0_) * 2u; g11 = (S.a_row(u, HALF + R1_) * (unsigned)K + (unsigned)C1_) * 2u; } while (0)
    Unit cur, nxt; int ui = 0;
    if (!S.next(0, cur)) return;
    f32x4 acc[2][2][4][2];
#pragma unroll
    for (int a = 0; a < 2; ++a)
#pragma unroll
        for (int b = 0; b < 2; ++b)
#pragma unroll
            for (int m = 0; m < 4; ++m)
#pragma unroll
                for (int n = 0; n < 2; ++n) acc[a][b][m][n] = (f32x4){0.f, 0.f, 0.f, 0.f};
    bf16x8 At[4][2], B0[2][2], B1[2][2];
    unsigned g00 = 0, g01 = 0, g10 = 0, g11 = 0;
    const char* cA = (const char*)A;
    if constexpr (Sched::GATHER) { PG8_GOFF(cur); } else { cA = (const char*)A + (size_t)S.a_row(cur, 0) * K * 2; }
    const char* cB = (const char*)Bt + S.b_off(cur);
    PG8_STAGEB(PG8_SB(0, 0), cB); PG8_STAGEB(PG8_SB(0, 1), cB + hstep); PG8_STAGEA(PG8_SA(0, 0), 0, 0); PG8_STAGEA(PG8_SA(0, 1), 1, 0);
    if (wr == 1) PG8_BAR;
    PG8_WAIT_V(2); PG8_BAR;
    PG8_STAGEB(PG8_SB(1, 0), cB + kstep); PG8_STAGEA(PG8_SA(1, 0), 0, kstep); PG8_STAGEB(PG8_SB(1, 1), cB + hstep + kstep);
    PG8_WAIT_V(6); PG8_BAR;
    for (;;) {
        const bool has_next = S.next(ui + 1, nxt);
        const char* nB = has_next ? (const char*)Bt + S.b_off(nxt) : cB;
#pragma nounroll
        for (int t = 0; t < nt; t += 2) {
            const bool last = (t == nt - 2);
            const size_t k1 = (size_t)(t + 1) * kstep;
            const size_t k2 = last ? 0 : (size_t)(t + 2) * kstep, k3 = k2 + kstep;
            const char* b2 = last ? nB : cB + (size_t)(t + 2) * kstep; const char* b3 = b2 + kstep;
            PG8_LDB(B0, 0, 0); if constexpr (VAR != 1) PG8_LDB(B1, 0, 1); PG8_SCHED; PG8_LDA(At, 0, 0); PG8_STAGEA(PG8_SA(1, 1), 1, k1);
            PG8_WAIT_V(8); PG8_WAIT_L(0); PG8_BAR; PG8_MMA(0, 0, At, B0); if constexpr (VAR != 1) PG8_MMA(0, 1, At, B1); PG8_BAR; PG8_SCHED;
            if (last && has_next) { if constexpr (Sched::GATHER) { PG8_GOFF(nxt); } else { cA = (const char*)A + (size_t)S.a_row(nxt, 0) * K * 2; } }
            if constexpr (VAR != 2) PG8_LDA(At, 0, 1); PG8_STAGEB(PG8_SB(0, 0), b2); PG8_STAGEB(PG8_SB(0, 1), b2 + hstep); PG8_STAGEA(PG8_SA(0, 0), 0, k2);
            PG8_WAIT_V(8); PG8_WAIT_L(0); PG8_BAR; if constexpr (VAR != 2) { PG8_MMA(1, 0, At, B0); if constexpr (VAR != 1) PG8_MMA(1, 1, At, B1); } PG8_BAR; PG8_SCHED;
            PG8_LDB(B0, 1, 0); if constexpr (VAR != 1) PG8_LDB(B1, 1, 1); PG8_SCHED; PG8_LDA(At, 1, 0); PG8_STAGEA(PG8_SA(0, 1), 1, k2);
            PG8_WAIT_V(8); PG8_WAIT_L(0); PG8_BAR; PG8_MMA(0, 0, At, B0); if constexpr (VAR != 1) PG8_MMA(0, 1, At, B1); PG8_BAR; PG8_SCHED;
            if constexpr (VAR != 2) PG8_LDA(At, 1, 1); PG8_STAGEB(PG8_SB(1, 0), b3); PG8_STAGEB(PG8_SB(1, 1), b3 + hstep); PG8_STAGEA(PG8_SA(1, 0), 0, k3);
            PG8_WAIT_V(8); PG8_WAIT_L(0); PG8_BAR; if constexpr (VAR != 2) { PG8_MMA(1, 0, At, B0); if constexpr (VAR != 1) PG8_MMA(1, 1, At, B1); } PG8_BAR; PG8_SCHED;
        }
        if (wr == 0) PG8_BAR;
        { int fr_ = fr, fq_ = fq; asm volatile("" : "+v"(fr_), "+v"(fq_));
          E(acc, cur, wr, wc, fr_, fq_); }
        if (!has_next) break;
#pragma unroll
        for (int a = 0; a < 2; ++a)
#pragma unroll
            for (int b = 0; b < 2; ++b)
#pragma unroll
                for (int m = 0; m < 4; ++m)
#pragma unroll
                    for (int n = 0; n < 2; ++n) acc[a][b][m][n] = (f32x4){0.f, 0.f, 0.f, 0.f};
        cur = nxt; cB = nB; ++ui;
        if (wr == 1) PG8_BAR;
    }
    PG8_WAIT_V(0);
    PG8_BAR;
#undef PG8_SA
#undef PG8_SB
#undef PG8_STAGEA
#undef PG8_STAGEB
#undef PG8_LDA
#undef PG8_LDB
#undef PG8_MMA
#undef PG8_WAIT_V
#undef PG8_WAIT_L
#undef PG8_BAR
#undef PG8_SCHED
#undef PG8_GOFF
}
}

struct EpiStore {
    static constexpr bool PERM = true;
    bf16* O; int ldc;
    __device__ __forceinline__ void operator()(const f32x4 (&acc)[2][2][4][2], const pg8::Unit& u, int wr, int wc, int fr, int fq) const {
        const int row0 = u.pm * 256 + wr * 64 + fr, col0 = u.pn * 256 + wc * 32 + 8 * fq;
#pragma unroll
        for (int ai = 0; ai < 2; ++ai)
#pragma unroll
            for (int m = 0; m < 4; ++m) { bf16* rowp = O + (size_t)(row0 + ai * 128 + m * 16) * ldc + col0;
#pragma unroll
                for (int bj = 0; bj < 2; ++bj) { const f32x4 v0 = acc[ai][bj][m][0], v1 = acc[ai][bj][m][1];
                    u32x4 w; w.x = cvtpk(v0[0], v0[1]); w.y = cvtpk(v0[2], v0[3]); w.z = cvtpk(v1[0], v1[1]); w.w = cvtpk(v1[2], v1[3]);
                    *(u32x4*)(rowp + bj * 128) = w; } }
    }
};
struct EpiStoreHalfM {
    static constexpr bool PERM = true;
    bf16* O; int ldc;
    __device__ __forceinline__ void operator()(const f32x4 (&acc)[2][2][4][2], const pg8::Unit& u, int wr, int wc, int fr, int fq) const {
        const int row0 = u.pm * 256 + u.hf * 128 + wr * 64 + fr, col0 = u.pn * 256 + wc * 32 + 8 * fq;
#pragma unroll
        for (int m = 0; m < 4; ++m) { bf16* rowp = O + (size_t)(row0 + m * 16) * ldc + col0;
#pragma unroll
            for (int bj = 0; bj < 2; ++bj) { const f32x4 v0 = acc[0][bj][m][0], v1 = acc[0][bj][m][1];
                u32x4 w; w.x = cvtpk(v0[0], v0[1]); w.y = cvtpk(v0[2], v0[3]); w.z = cvtpk(v1[0], v1[1]); w.w = cvtpk(v1[2], v1[3]);
                *(u32x4*)(rowp + bj * 128) = w; } }
    }
};
struct EpiStoreHalf {
    static constexpr bool PERM = true;
    bf16* O; int ldc;
    __device__ __forceinline__ void operator()(const f32x4 (&acc)[2][2][4][2], const pg8::Unit& u, int wr, int wc, int fr, int fq) const {
        const int row0 = u.pm * 256 + wr * 64 + fr, col0 = u.pn * 256 + wc * 32 + 8 * fq;
#pragma unroll
        for (int ai = 0; ai < 2; ++ai)
#pragma unroll
            for (int m = 0; m < 4; ++m) { bf16* rowp = O + (size_t)(row0 + ai * 128 + m * 16) * ldc + col0;
                const f32x4 v0 = acc[ai][0][m][0], v1 = acc[ai][0][m][1];
                u32x4 w; w.x = cvtpk(v0[0], v0[1]); w.y = cvtpk(v0[2], v0[3]); w.z = cvtpk(v1[0], v1[1]); w.w = cvtpk(v1[2], v1[3]);
                *(u32x4*)rowp = w; }
    }
};
constexpr float MLA_QS = 0.10411740f;
struct EpiQmla {
    static constexpr bool PERM = true;
    bf16* Q; const float* rp;
    __device__ __forceinline__ void operator()(const f32x4 (&acc)[2][2][4][2], const pg8::Unit& u, int wr, int wc, int fr, int fq) const {
        const int row0 = u.pm * 256 + wr * 64 + fr;
        if (u.pn < 2) {
#pragma unroll
            for (int ai = 0; ai < 2; ++ai)
#pragma unroll
                for (int m = 0; m < 4; ++m) { const int n = row0 + ai * 128 + m * 16;
#pragma unroll
                    for (int bj = 0; bj < 2; ++bj) { const f32x4 v0 = acc[ai][bj][m][0] * MLA_QS, v1 = acc[ai][bj][m][1] * MLA_QS;
                        u32x4 w; w.x = cvtpk(v0[0], v0[1]); w.y = cvtpk(v0[2], v0[3]); w.z = cvtpk(v1[0], v1[1]); w.w = cvtpk(v1[2], v1[3]);
                        *(u32x4*)(Q + (size_t)n * 768 + (2 * u.pn + bj) * 192 + wc * 32 + 8 * fq) = w; } }
        } else {
#pragma unroll
            for (int ai = 0; ai < 2; ++ai)
#pragma unroll
                for (int m = 0; m < 4; ++m) { const int n = row0 + ai * 128 + m * 16;
                    f32x4 a0 = acc[ai][0][m][0] * MLA_QS, a1 = acc[ai][0][m][1] * MLA_QS, b0 = acc[ai][1][m][0] * MLA_QS, b1 = acc[ai][1][m][1] * MLA_QS;
#ifdef PROBE_NOROPE
                    if (false) { const int rl = n & 255, prow = (u.pm & 31) * 4 + (rl >> 6), pcol = rl & 63;
#else
                    if (u.pm < 64) { const int rl = n & 255, prow = (u.pm & 31) * 4 + (rl >> 6), pcol = rl & 63;
#endif
                        const float* cp = (fq < 2) ? (rp + prow * 16 + 8 * fq) : (rp + 4096 + pcol * 16 + 8 * (fq - 2));
                        const float* sp = cp + ((fq < 2) ? 2048 : 1024);
                        const f32x4 c0 = *(const f32x4*)cp, c1 = *(const f32x4*)(cp + 4), s0 = *(const f32x4*)sp, s1 = *(const f32x4*)(sp + 4);
                        const f32x4 o0 = a0 * c0 - b0 * s0, o1 = a1 * c1 - b1 * s1, p0 = b0 * c0 + a0 * s0, p1 = b1 * c1 + a1 * s1;
                        a0 = o0; a1 = o1; b0 = p0; b1 = p1; }
                    u32x4 w; w.x = cvtpk(a0[0], a0[1]); w.y = cvtpk(a0[2], a0[3]); w.z = cvtpk(a1[0], a1[1]); w.w = cvtpk(a1[2], a1[3]);
                    bf16* dst = Q + (size_t)n * 768 + wc * 192 + 128 + 8 * fq;
                    *(u32x4*)dst = w;
                    w.x = cvtpk(b0[0], b0[1]); w.y = cvtpk(b0[2], b0[3]); w.z = cvtpk(b1[0], b1[1]); w.w = cvtpk(b1[2], b1[3]);
                    *(u32x4*)(dst + 32) = w; }
        }
    }
};
struct EpiKVmla {
    static constexpr bool PERM = true;
    bf16* Kd; bf16* Vd;
    __device__ __forceinline__ void operator()(const f32x4 (&acc)[2][2][4][2], const pg8::Unit& u, int wr, int wc, int fr, int fq) const {
        const int b = (u.pm < 64) ? (u.pm >> 5) : (u.pm - 64), pos0 = (u.pm < 64) ? (CTXL + (u.pm & 31) * 256) : 0;
        bf16* kb = Kd + ((size_t)(b * 4 + u.pn) * SKV + pos0) * 192 + wc * 32 + 8 * fq;
        bf16* vb = Vd + ((size_t)(b * 4 + u.pn) * SKV + pos0) * 128 + wc * 32 + 8 * fq;
        const int r0 = wr * 64 + fr;
#pragma unroll
        for (int ai = 0; ai < 2; ++ai)
#pragma unroll
            for (int m = 0; m < 4; ++m) { const int r = r0 + ai * 128 + m * 16;
                { const f32x4 v0 = acc[ai][0][m][0], v1 = acc[ai][0][m][1];
                  u32x4 w; w.x = cvtpk(v0[0], v0[1]); w.y = cvtpk(v0[2], v0[3]); w.z = cvtpk(v1[0], v1[1]); w.w = cvtpk(v1[2], v1[3]);
                  *(u32x4*)(kb + r * 192) = w; }
                { const f32x4 v0 = acc[ai][1][m][0], v1 = acc[ai][1][m][1];
                  u32x4 w; w.x = cvtpk(v0[0], v0[1]); w.y = cvtpk(v0[2], v0[3]); w.z = cvtpk(v1[0], v1[1]); w.w = cvtpk(v1[2], v1[3]);
                  *(u32x4*)(vb + r * 128) = w; } }
    }
};
struct EpiGLU {
    static constexpr bool PERM = true;
    bf16* H; const float* roww; const LAS int* cnt;
    __device__ __forceinline__ void operator()(const f32x4 (&acc)[2][2][4][2], const pg8::Unit& u, int wr, int wc, int fr, int fq) const {
        const int ne = u.ne;
        float cwv[2][4];
#pragma unroll
        for (int ai = 0; ai < 2; ++ai)
#pragma unroll
            for (int m = 0; m < 4; ++m) { const int pos = u.j * 256 + ai * 128 + wr * 64 + m * 16 + fr; cwv[ai][m] = (pos < ne) ? roww[(size_t)u.e * M + pos] : 0.f; }
#pragma unroll
        for (int ai = 0; ai < 2; ++ai)
#pragma unroll
            for (int m = 0; m < 4; ++m) { const int r = ai * 128 + wr * 64 + m * 16 + fr;
                const float cw = cwv[ai][m];
                f32x4 h0, h1;
#pragma unroll
                for (int q = 0; q < 4; ++q) { const float g0 = acc[ai][0][m][0][q], g1 = acc[ai][0][m][1][q];
                    h0[q] = siluf_(g0) * acc[ai][1][m][0][q] * cw; h1[q] = siluf_(g1) * acc[ai][1][m][1][q] * cw; }
                u32x4 w; w.x = cvtpk(h0[0], h0[1]); w.y = cvtpk(h0[2], h0[3]); w.z = cvtpk(h1[0], h1[1]); w.w = cvtpk(h1[2], h1[3]);
                *(u32x4*)(H + (size_t)(u.pm * 256 + r) * DEXP + u.pn * 128 + wc * 32 + 8 * fq) = w; }
    }
};
struct EpiGLUHalf {
    static constexpr bool PERM = true;
    bf16* H; const float* roww; const LAS int* cnt;
    __device__ __forceinline__ void operator()(const f32x4 (&acc)[2][2][4][2], const pg8::Unit& u, int wr, int wc, int fr, int fq) const {
        const int ne = u.ne;
        float cwv[4];
#pragma unroll
        for (int m = 0; m < 4; ++m) { const int pos = u.j * 256 + u.hf * 128 + wr * 64 + m * 16 + fr; cwv[m] = (pos < ne) ? roww[(size_t)u.e * M + pos] : 0.f; }
#pragma unroll
        for (int m = 0; m < 4; ++m) { const int r = u.hf * 128 + wr * 64 + m * 16 + fr;
            const float cw = cwv[m];
            f32x4 h0, h1;
#pragma unroll
            for (int q = 0; q < 4; ++q) { const float g0 = acc[0][0][m][0][q], g1 = acc[0][0][m][1][q];
                h0[q] = siluf_(g0) * acc[0][1][m][0][q] * cw; h1[q] = siluf_(g1) * acc[0][1][m][1][q] * cw; }
            u32x4 w; w.x = cvtpk(h0[0], h0[1]); w.y = cvtpk(h0[2], h0[3]); w.z = cvtpk(h1[0], h1[1]); w.w = cvtpk(h1[2], h1[3]);
            *(u32x4*)(H + (size_t)(u.pm * 256 + r) * DEXP + u.pn * 128 + wc * 32 + 8 * fq) = w; }
    }
};
struct MoeDeal {
    int G, c, ncol_shift; const LAS int* tp;
    __device__ __forceinline__ bool unit(int i, int& rt, int& pn) const {
        const int R = __builtin_amdgcn_readfirstlane(tp[16]), ncol = 1 << ncol_shift;
        if (G == 256) { const int x = c & 7, y = c >> 3, q = R >> 3, r = R & 7, base = x * q + (x < r ? x : r), cnt = q + (x < r ? 1 : 0);
            const int k = i * 32 + y; if (k >= cnt * ncol) return false; rt = base + (k >> ncol_shift); pn = k & (ncol - 1); return true; }
        const int L = i * G + c; if (L >= R * ncol) return false; rt = L >> ncol_shift; pn = L & (ncol - 1); return true;
    }
};
struct MoeOrder1 {
    static constexpr bool GATHER = true;
    int G, c; const LAS int* tp; const LAS int* cnt; const int* list; int maxr;
    __device__ bool next(int i, pg8::Unit& u) const {
        if (i >= maxr) return false;
        int rt, pn; const MoeDeal dl{G, c, 2, tp}; if (!dl.unit(i, rt, pn)) return false;
        int e = 0;
#pragma unroll
        for (int k = 1; k < 16; ++k) e += (rt >= __builtin_amdgcn_readfirstlane(tp[k])) ? 1 : 0;
        u.pm = rt; u.pn = pn; u.e = e; u.j = rt - __builtin_amdgcn_readfirstlane(tp[e]); u.ne = __builtin_amdgcn_readfirstlane(cnt[e]); u.hf = 0; return true;
    }
    __device__ __forceinline__ unsigned a_row(const pg8::Unit& u, int r) const { const int pos = u.j * 256 + r; return (pos < u.ne) ? (unsigned)list[(size_t)u.e * M + pos] : 0u; }
    __device__ __forceinline__ size_t b_off(const pg8::Unit& u) const { return ((size_t)u.e * 1024 + (size_t)u.pn * 256) * D * 2; }
};
struct MoeOrder1Tail {
    static constexpr bool GATHER = true;
    int G, c; const LAS int* tp; const LAS int* cnt; const int* list;
    __device__ bool next(int i, pg8::Unit& u) const {
        if (i > 0) return false;
        const int y = c >> 3; int rt, pn; const MoeDeal dl{G, (c & 7) | (((y >> 1) & 31) << 3), 2, tp}; if (!dl.unit(2, rt, pn)) return false;
        int e = 0;
#pragma unroll
        for (int k = 1; k < 16; ++k) e += (rt >= __builtin_amdgcn_readfirstlane(tp[k])) ? 1 : 0;
        u.pm = rt; u.pn = pn; u.e = e; u.j = rt - __builtin_amdgcn_readfirstlane(tp[e]); u.ne = __builtin_amdgcn_readfirstlane(cnt[e]); u.hf = y & 1; return true;
    }
    __device__ __forceinline__ unsigned a_row(const pg8::Unit& u, int r) const { const int pos = u.j * 256 + u.hf * 128 + (r & 127); return (pos < u.ne) ? (unsigned)list[(size_t)u.e * M + pos] : 0u; }
    __device__ __forceinline__ size_t b_off(const pg8::Unit& u) const { return ((size_t)u.e * 1024 + (size_t)u.pn * 256) * D * 2; }
};
struct MoeOrder2 {
    static constexpr bool GATHER = false;
    int G, c; const LAS int* tp; int maxr;
    __device__ bool next(int i, pg8::Unit& u) const {
        if (i >= maxr) return false;
        int rt, pn; const MoeDeal dl{G, c, 3, tp}; if (!dl.unit(i, rt, pn)) return false;
        int e = 0;
#pragma unroll
        for (int k = 1; k < 16; ++k) e += (rt >= __builtin_amdgcn_readfirstlane(tp[k])) ? 1 : 0;
        u.pm = rt; u.pn = pn; u.e = e; u.j = rt - __builtin_amdgcn_readfirstlane(tp[e]); u.ne = 0; u.hf = 0; return true;
    }
    __device__ __forceinline__ unsigned a_row(const pg8::Unit& u, int r) const { return (unsigned)(u.pm * 256 + r); }
    __device__ __forceinline__ size_t b_off(const pg8::Unit& u) const { return ((size_t)u.e * D + (size_t)u.pn * 256) * DEXP * 2; }
};
struct MoeOrder2Tail {
    static constexpr bool GATHER = false;
    int G, c; const LAS int* tp;
    __device__ bool next(int i, pg8::Unit& u) const {
        const int hh = i * 32 + (c >> 3), k = hh >> 1; if (k >= 32) return false;
        int rt, pn; const MoeDeal dl{G, (c & 7) | (k << 3), 3, tp}; if (!dl.unit(4, rt, pn)) return false;
        int e = 0;
#pragma unroll
        for (int q = 1; q < 16; ++q) e += (rt >= __builtin_amdgcn_readfirstlane(tp[q])) ? 1 : 0;
        u.pm = rt; u.pn = pn; u.e = e; u.j = rt - __builtin_amdgcn_readfirstlane(tp[e]); u.ne = 0; u.hf = hh & 1; return true;
    }
    __device__ __forceinline__ unsigned a_row(const pg8::Unit& u, int r) const { return (unsigned)(u.pm * 256 + u.hf * 128 + (r & 127)); }
    __device__ __forceinline__ size_t b_off(const pg8::Unit& u) const { return ((size_t)u.e * D + (size_t)u.pn * 256) * DEXP * 2; }
};

namespace att {
constexpr int NW = 8, QBLK = 32, KVBLK = 64;
constexpr float THR = 8.f;
constexpr int SHM_V = KVBLK * 128 * 2, SHM_K = KVBLK * 128 * 2, SHM_KR = KVBLK * 64 * 2;
constexpr int OFF_V = 0, OFF_K = 2 * SHM_V, OFF_WS = OFF_K + 2 * SHM_K, OFF_KR = OFF_WS + NW * 64 * 4, OFF_QR = OFF_KR + 2 * SHM_KR, LDS_END = OFF_QR + 256 * 128;
static_assert(LDS_END <= LDS_MISC, "attention LDS");
#define KSWZ(row, colB) ((row) * 256 + ((colB) ^ (((row) & 7) << 4)))
#define RSWZ(row, ch) ((row) * 128 + ((((ch) ^ ((row) >> 1)) & 7) << 4))
__device__ __forceinline__ int crow(int r, int hi) { return (r & 3) + 8 * (r >> 2) + 4 * hi; }

template <int DQK, int MODE>
__device__ __forceinline__ void partialSM(f32x16& p0, f32x16& p1, float& m_reg, float& mn, float& alpha) {
    if constexpr (MODE == 2) {
        alpha = 1.f; mn = 0.f;
#pragma unroll
        for (int r = 0; r < 16; ++r) p0[r] = __builtin_amdgcn_exp2f(p0[r]);
        return;
    }
    constexpr float SCALE = (MODE == 1) ? 0.6931471805599453f : ((DQK == 128) ? 0.088388347648318440f : 0.072168783648703220f);
    constexpr float C = SCALE * 1.4426950408889634f;
    float pmax = p0[0];
#pragma unroll
    for (int r = 1; r < 16; ++r) pmax = fmaxf(pmax, p0[r]);
#pragma unroll
    for (int r = 0; r < 16; ++r) pmax = fmaxf(pmax, p1[r]);
    { auto rr = __builtin_amdgcn_permlane32_swap(__float_as_uint(pmax), __float_as_uint(pmax), false, false);
      pmax = fmaxf(__uint_as_float(rr[0]), __uint_as_float(rr[1])); }
    if (__builtin_expect(__all(pmax - m_reg <= THR / SCALE), 1)) { mn = m_reg; alpha = 1.f; }
    else { mn = fmaxf(m_reg, pmax); alpha = __builtin_amdgcn_exp2f((m_reg - mn) * C); m_reg = mn; }
    const float mnC = -mn * C;
#pragma unroll
    for (int r = 0; r < 16; ++r) p0[r] = fmaf(p0[r], C, mnC);
#pragma unroll
    for (int r = 0; r < 16; ++r) p1[r] = fmaf(p1[r], C, mnC);
#pragma unroll
    for (int r = 0; r < 16; ++r) p0[r] = __builtin_amdgcn_exp2f(p0[r]);
}
__device__ __forceinline__ void finishSM_a(f32x16& p1) {
#pragma unroll
    for (int r = 0; r < 16; ++r) p1[r] = __builtin_amdgcn_exp2f(p1[r]);
}
template <bool EXPDONE = false>
__device__ __forceinline__ void finishSM(f32x16& p0, f32x16& p1, float alpha, float& l_reg, bf16x8& pa0, bf16x8& pa1, bf16x8& pa2, bf16x8& pa3) {
    if constexpr (!EXPDONE) {
#pragma unroll
    for (int r = 0; r < 16; ++r) p1[r] = __builtin_amdgcn_exp2f(p1[r]);
    }
    float ps = 0;
#pragma unroll
    for (int r = 0; r < 16; ++r) ps += p0[r];
#pragma unroll
    for (int r = 0; r < 16; ++r) ps += p1[r];
    { auto rr = __builtin_amdgcn_permlane32_swap(__float_as_uint(ps), __float_as_uint(ps), false, false);
      ps = __uint_as_float(rr[0]) + __uint_as_float(rr[1]); }
    l_reg = l_reg * alpha + ps;
#define PK4(P, BASE, OUT) do { unsigned a0 = cvtpk(P[BASE + 0], P[BASE + 1]), a1 = cvtpk(P[BASE + 2], P[BASE + 3]);   \
    unsigned b0 = cvtpk(P[BASE + 4], P[BASE + 5]), b1 = cvtpk(P[BASE + 6], P[BASE + 7]);                              \
    auto r0 = __builtin_amdgcn_permlane32_swap(a0, b0, false, false); auto r1 = __builtin_amdgcn_permlane32_swap(a1, b1, false, false); \
    u32x4 w = {r0[0], r1[0], r0[1], r1[1]}; OUT = *reinterpret_cast<bf16x8*>(&w); } while (0)
    PK4(p0, 0, pa0); PK4(p0, 8, pa1); PK4(p1, 0, pa2); PK4(p1, 8, pa3);
#undef PK4
}
template <int DQK, int KPF = 0>
__device__ __forceinline__ void qkt(f32x16& p0, f32x16& p1, const char* Ks, const char* KRs, const char* QRs, const bf16x8* qr, int r32, int hi, int qrow) {
    p0 = f32x16{}; p1 = f32x16{};
    if constexpr ((KPF & 1) != 0) {
#define QK_RD(d0_, B0_, B1_) do { const int cb_ = ((d0_) * 16 + hi * 8) * 2; B0_ = *reinterpret_cast<const bf16x8*>(Ks + KSWZ(r32, cb_)); B1_ = *reinterpret_cast<const bf16x8*>(Ks + KSWZ(32 + r32, cb_)); } while (0)
        bf16x8 a0, a1, c0, c1;
        QK_RD(0, a0, a1);
#pragma unroll
        for (int d0 = 0; d0 < 8; d0 += 2) {
            QK_RD(d0 + 1, c0, c1); SBAR();
            p0 = __builtin_amdgcn_mfma_f32_32x32x16_bf16(a0, qr[d0], p0, 0, 0, 0); p1 = __builtin_amdgcn_mfma_f32_32x32x16_bf16(a1, qr[d0], p1, 0, 0, 0); SBAR();
            if (d0 + 2 < 8) { QK_RD(d0 + 2, a0, a1); } SBAR();
            p0 = __builtin_amdgcn_mfma_f32_32x32x16_bf16(c0, qr[d0 + 1], p0, 0, 0, 0); p1 = __builtin_amdgcn_mfma_f32_32x32x16_bf16(c1, qr[d0 + 1], p1, 0, 0, 0); SBAR();
        }
#undef QK_RD
    } else {
#pragma unroll
    for (int d0 = 0; d0 < 8; ++d0) { const int cb = (d0 * 16 + hi * 8) * 2;
        bf16x8 b0 = *reinterpret_cast<const bf16x8*>(Ks + KSWZ(r32, cb));
        bf16x8 b1 = *reinterpret_cast<const bf16x8*>(Ks + KSWZ(32 + r32, cb));
        p0 = __builtin_amdgcn_mfma_f32_32x32x16_bf16(b0, qr[d0], p0, 0, 0, 0);
        p1 = __builtin_amdgcn_mfma_f32_32x32x16_bf16(b1, qr[d0], p1, 0, 0, 0); }
    }
    if constexpr (DQK == 192) {
        SBAR();
#pragma unroll
        for (int d0 = 0; d0 < 4; ++d0) { const int ch = d0 * 2 + hi;
            bf16x8 b0 = *reinterpret_cast<const bf16x8*>(KRs + RSWZ(r32, ch));
            bf16x8 b1 = *reinterpret_cast<const bf16x8*>(KRs + RSWZ(32 + r32, ch));
            bf16x8 q = *reinterpret_cast<const bf16x8*>(QRs + RSWZ(qrow, ch));
            p0 = __builtin_amdgcn_mfma_f32_32x32x16_bf16(b0, q, p0, 0, 0, 0);
            p1 = __builtin_amdgcn_mfma_f32_32x32x16_bf16(b1, q, p1, 0, 0, 0); }
    }
}
#define QK_RD2(d0_, B0_, B1_) do { const int cb_ = ((d0_) * 16 + hi * 8) * 2; B0_ = *reinterpret_cast<const bf16x8*>(Ks + KSWZ(r32, cb_)); B1_ = *reinterpret_cast<const bf16x8*>(Ks + KSWZ(32 + r32, cb_)); } while (0)
__device__ __forceinline__ void qk_pre(const char* Ks, int r32, int hi, bf16x8& a0, bf16x8& a1, bf16x8& c0, bf16x8& c1) { QK_RD2(0, a0, a1); QK_RD2(1, c0, c1); SBAR(); }
__device__ __forceinline__ void qk_main(f32x16& p0, f32x16& p1, const char* Ks, const bf16x8* qr, int r32, int hi, bf16x8 a0, bf16x8 a1, bf16x8 c0, bf16x8 c1) {
    p0 = f32x16{}; p1 = f32x16{};
#pragma unroll
    for (int d0 = 0; d0 < 8; d0 += 2) {
        if (d0 > 0) { QK_RD2(d0 + 1, c0, c1); } SBAR();
        p0 = __builtin_amdgcn_mfma_f32_32x32x16_bf16(a0, qr[d0], p0, 0, 0, 0); p1 = __builtin_amdgcn_mfma_f32_32x32x16_bf16(a1, qr[d0], p1, 0, 0, 0); SBAR();
        if (d0 + 2 < 8) { QK_RD2(d0 + 2, a0, a1); } SBAR();
        p0 = __builtin_amdgcn_mfma_f32_32x32x16_bf16(c0, qr[d0 + 1], p0, 0, 0, 0); p1 = __builtin_amdgcn_mfma_f32_32x32x16_bf16(c1, qr[d0 + 1], p1, 0, 0, 0); SBAR();
    }
}
#undef QK_RD2
__device__ __forceinline__ int v_st(int k, int c) { const int kk = (k & ~0xC) | ((k & 4) << 1) | ((k & 8) >> 1); return ((kk >> 3) * 4 + (c >> 5)) * 512 + ((kk & 7) * 32 + (c & 31)) * 2; }
__device__ __forceinline__ int v_rd_base(int lane) { return ((lane & 3) << 3) | (((lane >> 2) & 3) << 6) | (((lane >> 4) & 1) << 5) | (((lane >> 5) & 1) << 8); }
constexpr int v_rd_off(int d0, int ks, int half) { return d0 * 512 + ks * 4096 + half * 2048; }
template <int OFF> __device__ __forceinline__ s16x4 tr_read(int vb) {
    s16x4 r; asm volatile("ds_read_b64_tr_b16 %0, %1 offset:%2" : "=&v"(r) : "v"(vb), "i"(OFF) : "memory"); return r;
}
template <int D0> __device__ __forceinline__ void pv_one(f32x16& od, int vb, bf16x8 pa0, bf16x8 pa1, bf16x8 pa2, bf16x8 pa3) {
    const s16x4 l0 = tr_read<v_rd_off(D0, 0, 0)>(vb), h0 = tr_read<v_rd_off(D0, 0, 1)>(vb), l1 = tr_read<v_rd_off(D0, 1, 0)>(vb), h1 = tr_read<v_rd_off(D0, 1, 1)>(vb);
    const s16x4 l2 = tr_read<v_rd_off(D0, 2, 0)>(vb), h2 = tr_read<v_rd_off(D0, 2, 1)>(vb), l3 = tr_read<v_rd_off(D0, 3, 0)>(vb), h3 = tr_read<v_rd_off(D0, 3, 1)>(vb);
    asm volatile("s_waitcnt lgkmcnt(0)" ::: "memory"); SBAR();
#define PK(L, H) (bf16x8){L[0], L[1], L[2], L[3], H[0], H[1], H[2], H[3]}
    od = __builtin_amdgcn_mfma_f32_32x32x16_bf16(pa0, PK(l0, h0), od, 0, 0, 0);
    od = __builtin_amdgcn_mfma_f32_32x32x16_bf16(pa1, PK(l1, h1), od, 0, 0, 0);
    od = __builtin_amdgcn_mfma_f32_32x32x16_bf16(pa2, PK(l2, h2), od, 0, 0, 0);
    od = __builtin_amdgcn_mfma_f32_32x32x16_bf16(pa3, PK(l3, h3), od, 0, 0, 0);
#undef PK
}
__device__ __forceinline__ void pv_d0(f32x16* o, int vb, bf16x8 pa0, bf16x8 pa1, bf16x8 pa2, bf16x8 pa3) {
    pv_one<0>(o[0], vb, pa0, pa1, pa2, pa3); pv_one<1>(o[1], vb, pa0, pa1, pa2, pa3); pv_one<2>(o[2], vb, pa0, pa1, pa2, pa3); pv_one<3>(o[3], vb, pa0, pa1, pa2, pa3);
}
struct VPre { s16x4 l0, h0, l1, h1, l2, h2, l3, h3; };
__device__ __forceinline__ void pv_prefetch(VPre& f, int vb) {
    f.l0 = tr_read<v_rd_off(0, 0, 0)>(vb); f.h0 = tr_read<v_rd_off(0, 0, 1)>(vb); f.l1 = tr_read<v_rd_off(0, 1, 0)>(vb); f.h1 = tr_read<v_rd_off(0, 1, 1)>(vb);
    f.l2 = tr_read<v_rd_off(0, 2, 0)>(vb); f.h2 = tr_read<v_rd_off(0, 2, 1)>(vb); f.l3 = tr_read<v_rd_off(0, 3, 0)>(vb); f.h3 = tr_read<v_rd_off(0, 3, 1)>(vb); SBAR();
}
__device__ __forceinline__ void pv_d0_pre(f32x16* o, int vb, const VPre& f, bf16x8 pa0, bf16x8 pa1, bf16x8 pa2, bf16x8 pa3) {
    asm volatile("s_waitcnt lgkmcnt(0)" ::: "memory"); SBAR();
#define PK(L, H) (bf16x8){L[0], L[1], L[2], L[3], H[0], H[1], H[2], H[3]}
    o[0] = __builtin_amdgcn_mfma_f32_32x32x16_bf16(pa0, PK(f.l0, f.h0), o[0], 0, 0, 0);
    o[0] = __builtin_amdgcn_mfma_f32_32x32x16_bf16(pa1, PK(f.l1, f.h1), o[0], 0, 0, 0);
    o[0] = __builtin_amdgcn_mfma_f32_32x32x16_bf16(pa2, PK(f.l2, f.h2), o[0], 0, 0, 0);
    o[0] = __builtin_amdgcn_mfma_f32_32x32x16_bf16(pa3, PK(f.l3, f.h3), o[0], 0, 0, 0);
#undef PK
    pv_one<1>(o[1], vb, pa0, pa1, pa2, pa3); pv_one<2>(o[2], vb, pa0, pa1, pa2, pa3); pv_one<3>(o[3], vb, pa0, pa1, pa2, pa3);
}
template <int DQK, int LDQ, int LDK, int LDO, int SD, int MODE, int KPF = 0>
__device__ __forceinline__ bool attn_body(const bf16* __restrict__ Qb, const bf16* __restrict__ Kh, const bf16* __restrict__ Vh, bf16* __restrict__ Ob, int seq, char* lds) {
    const int tid = opaque_tid(), wid = tid >> 6, lane = tid & 63, r32 = lane & 31, hi = lane >> 5;
    char* V_lds = lds + OFF_V; char* K_lds = lds + OFF_K; char* KR_lds = lds + OFF_KR; char* QR_lds = lds + OFF_QR;
    constexpr bool RING = (KPF & 128) != 0;
    float* ws = (float*)(lds + (RING ? 3 * SHM_V + 2 * SHM_K : OFF_WS)) + wid * 64; float* li_l = ws; float* al_l = ws + 32;
    float m_reg = -1e30f, l_reg = 0; f32x16 o[4] = {}; bf16x8 qr[8];
    const int qrow = wid * QBLK + r32;
    const bf16* Qw = Qb + (long)qrow * LDQ + hi * 8;
#pragma unroll
    for (int d0 = 0; d0 < 8; ++d0) { qr[d0] = *reinterpret_cast<const bf16x8*>(Qw + d0 * 16);
#ifdef PROBE_QZERO
        qr[d0] = (bf16x8){0, 0, 0, 0, 0, 0, 0, 0};
#endif
    }
    if constexpr (DQK == 192) {
#pragma unroll
        for (int d0 = 0; d0 < 4; ++d0) { bf16x8 q = *reinterpret_cast<const bf16x8*>(Qw + 128 + d0 * 16);
#ifdef PROBE_QZERO
            q = (bf16x8){0, 0, 0, 0, 0, 0, 0, 0};
#endif
            *reinterpret_cast<bf16x8*>(QR_lds + RSWZ(qrow, d0 * 2 + hi)) = q; }
    }
    const int sr = tid >> 4, sc = (tid & 15) * 8, vst0 = v_st(sr, sc), vst1 = v_st(32 + sr, sc);
    const int rr_ = tid >> 3, rc_ = tid & 7;
    const int vb0 = (int)(uintptr_t)V_lds + v_rd_base(lane);
    bf16x8 sv0[SD], sv1[SD], sk0[SD], sk1[SD], skr[SD];
#define SLOAD(i, k0) do { sv0[i] = *reinterpret_cast<const bf16x8*>(&Vh[(long)((k0) + sr) * 128 + sc]); sv1[i] = *reinterpret_cast<const bf16x8*>(&Vh[(long)((k0) + 32 + sr) * 128 + sc]); \
    sk0[i] = *reinterpret_cast<const bf16x8*>(&Kh[(long)((k0) + sr) * LDK + sc]); sk1[i] = *reinterpret_cast<const bf16x8*>(&Kh[(long)((k0) + 32 + sr) * LDK + sc]); \
    if constexpr (DQK == 192) skr[i] = *reinterpret_cast<const bf16x8*>(&Kh[(long)((k0) + rr_) * LDK + 128 + rc_ * 8]); } while (0)
#define SWRITE(b, i) do { *(bf16x8*)(V_lds + (b) * SHM_V + vst0) = sv0[i]; *(bf16x8*)(V_lds + (b) * SHM_V + vst1) = sv1[i]; const int kc = sc * 2; \
    *(bf16x8*)(K_lds + (b) * SHM_K + KSWZ(sr, kc)) = sk0[i]; *(bf16x8*)(K_lds + (b) * SHM_K + KSWZ(32 + sr, kc)) = sk1[i]; \
    if constexpr (DQK == 192) *(bf16x8*)(KR_lds + (b) * SHM_KR + RSWZ(rr_, rc_)) = skr[i]; } while (0)
#define SWAIT() do { if constexpr (SD == 1) asm volatile("s_waitcnt vmcnt(0)" ::: "memory"); else if constexpr (DQK == 192) asm volatile("s_waitcnt vmcnt(5)" ::: "memory"); else asm volatile("s_waitcnt vmcnt(4)" ::: "memory"); } while (0)
#define RESC(a) do { if (MODE != 2 && __any((a) < 1.f)) { if (hi == 0) al_l[r32] = (a); asm volatile("s_waitcnt lgkmcnt(0)" ::: "memory"); \
    _Pragma("unroll") for (int d = 0; d < 4; ++d) _Pragma("unroll") for (int r = 0; r < 16; ++r) o[d][r] *= al_l[crow(r, hi)]; } } while (0)
    f32x16 pA0, pA1, pB0, pB1; float mnA, mnB, alA, alB; bf16x8 pa0, pa1, pa2, pa3; const int NT = seq / KVBLK;
    if constexpr (RING) {
        char* Vr = lds; char* Kr = lds + 3 * SHM_V;
        const int vbr = (int)(uintptr_t)Vr + v_rd_base(lane);
#define RWRITE(vs_, ks_) do { *(bf16x8*)(Vr + (vs_) * SHM_V + vst0) = sv0[0]; *(bf16x8*)(Vr + (vs_) * SHM_V + vst1) = sv1[0]; const int kc = sc * 2; \
        *(bf16x8*)(Kr + (ks_) * SHM_K + KSWZ(sr, kc)) = sk0[0]; *(bf16x8*)(Kr + (ks_) * SHM_K + KSWZ(32 + sr, kc)) = sk1[0]; } while (0)
#define RHALF(X0, X1, alX, Y0, Y1, mnY, alY, ks_, LOAD_, tile_) do { \
        bf16x8 ka0, ka1, kc0, kc1; VPre vf; \
        SBAR(); qk_pre(Kr + (ks_) * SHM_K, r32, hi, ka0, ka1, kc0, kc1); \
        finishSM_a(X1); SBAR(); \
        qk_main(Y0, Y1, Kr + (ks_) * SHM_K, qr, r32, hi, ka0, ka1, kc0, kc1); \
        pv_prefetch(vf, vbr + vs_rd * (int)SHM_V); \
        finishSM<true>(X0, X1, alX, l_reg, pa0, pa1, pa2, pa3); SBAR(); \
        if (LOAD_) { SLOAD(0, (tile_) * KVBLK); } SBAR(); \
        pv_d0_pre(o, vbr + vs_rd * (int)SHM_V, vf, pa0, pa1, pa2, pa3); \
        partialSM<DQK, MODE>(Y0, Y1, m_reg, mnY, alY); \
        if (LOAD_) { asm volatile("s_waitcnt vmcnt(0)" ::: "memory"); RWRITE(vs_wr, (ks_) ^ 1); } \
        __syncthreads(); \
        vs_rd = (vs_rd == 2) ? 0 : vs_rd + 1; vs_wr = (vs_wr == 2) ? 0 : vs_wr + 1; } while (0)
        SLOAD(0, 0); asm volatile("s_waitcnt vmcnt(0)" ::: "memory"); RWRITE(0, 0); __syncthreads();
        qkt<DQK, 1>(pA0, pA1, Kr, nullptr, nullptr, qr, r32, hi, qrow); partialSM<DQK, MODE>(pA0, pA1, m_reg, mnA, alA);
        SLOAD(0, KVBLK); asm volatile("s_waitcnt vmcnt(0)" ::: "memory"); RWRITE(1, 1); __syncthreads();
        int vs_rd = 0, vs_wr = 2;
        if (__builtin_amdgcn_readfirstlane(wid) >= 4) __builtin_amdgcn_s_setprio(1);
        for (int t = 1; t + 1 < NT; t += 2) {
            RHALF(pA0, pA1, alA, pB0, pB1, mnB, alB, 1, true, t + 1);
            RHALF(pB0, pB1, alB, pA0, pA1, mnA, alA, 0, (t + 2 < NT), t + 2);
        }
        RHALF(pA0, pA1, alA, pB0, pB1, mnB, alB, 1, false, 0);
        __builtin_amdgcn_s_setprio(0);
        finishSM(pB0, pB1, alB, l_reg, pa0, pa1, pa2, pa3); SBAR();
        pv_d0(o, vbr + vs_rd * (int)SHM_V, pa0, pa1, pa2, pa3);
#undef RHALF
#undef RWRITE
    } else {
    constexpr int SE = 0, SO = SD - 1;
    SLOAD(SE, 0); asm volatile("s_waitcnt vmcnt(0)" ::: "memory"); SWRITE(0, SE); __syncthreads();
    qkt<DQK, KPF>(pA0, pA1, K_lds, KR_lds, QR_lds, qr, r32, hi, qrow); partialSM<DQK, MODE>(pA0, pA1, m_reg, mnA, alA);
    SLOAD(SO, KVBLK); if constexpr (SD == 2) { if (2 < NT) SLOAD(SE, 2 * KVBLK); }
    SWAIT(); SWRITE(1, SO); __syncthreads();
    if constexpr ((KPF & 4) != 0) {
      if (__builtin_amdgcn_readfirstlane(wid) >= 4) __builtin_amdgcn_s_setprio(1);
      for (int j = 1; j + 1 < NT; j += 2) {
        bf16x8 ka0, ka1, kc0, kc1; VPre vf;
        SBAR(); qk_pre(K_lds + SHM_K, r32, hi, ka0, ka1, kc0, kc1);
        finishSM_a(pA1); SBAR();
        qk_main(pB0, pB1, K_lds + SHM_K, qr, r32, hi, ka0, ka1, kc0, kc1);
        pv_prefetch(vf, vb0);
        finishSM<true>(pA0, pA1, alA, l_reg, pa0, pa1, pa2, pa3); SBAR();
        SLOAD(SO, (j + SD) * KVBLK); SBAR();
        pv_d0_pre(o, vb0, vf, pa0, pa1, pa2, pa3);
        partialSM<DQK, MODE>(pB0, pB1, m_reg, mnB, alB);
        __syncthreads(); SWAIT(); SWRITE(0, SE);
        RESC(alB); __syncthreads();
        SBAR(); qk_pre(K_lds, r32, hi, ka0, ka1, kc0, kc1);
        finishSM_a(pB1); SBAR();
        qk_main(pA0, pA1, K_lds, qr, r32, hi, ka0, ka1, kc0, kc1);
        pv_prefetch(vf, vb0 + (int)SHM_V);
        finishSM<true>(pB0, pB1, alB, l_reg, pa0, pa1, pa2, pa3); SBAR();
        if (SD == 1 || j + 3 < NT) SLOAD(SE, (j + 1 + SD) * KVBLK); SBAR();
        pv_d0_pre(o, vb0 + (int)SHM_V, vf, pa0, pa1, pa2, pa3);
        partialSM<DQK, MODE>(pA0, pA1, m_reg, mnA, alA);
        __syncthreads(); SWAIT(); SWRITE(1, SO);
        RESC(alA); __syncthreads();
      }
    } else
    for (int j = 1; j + 1 < NT; j += 2) {
        SBAR(); qkt<DQK, KPF>(pB0, pB1, K_lds + SHM_K, KR_lds + SHM_KR, QR_lds, qr, r32, hi, qrow);
        VPre vf; if constexpr ((KPF & 2) != 0) pv_prefetch(vf, vb0);
        finishSM(pA0, pA1, alA, l_reg, pa0, pa1, pa2, pa3); SBAR();
        SLOAD(SO, (j + SD) * KVBLK); SBAR();
        if constexpr ((KPF & 2) != 0) pv_d0_pre(o, vb0, vf, pa0, pa1, pa2, pa3); else pv_d0(o, vb0, pa0, pa1, pa2, pa3);
        partialSM<DQK, MODE>(pB0, pB1, m_reg, mnB, alB);
        __syncthreads(); SWAIT(); SWRITE(0, SE);
        RESC(alB); __syncthreads();
        SBAR(); qkt<DQK, KPF>(pA0, pA1, K_lds, KR_lds, QR_lds, qr, r32, hi, qrow);
        if constexpr ((KPF & 2) != 0) pv_prefetch(vf, vb0 + (int)SHM_V);
        finishSM(pB0, pB1, alB, l_reg, pa0, pa1, pa2, pa3); SBAR();
        if (SD == 1 || j + 3 < NT) SLOAD(SE, (j + 1 + SD) * KVBLK); SBAR();
        if constexpr ((KPF & 2) != 0) pv_d0_pre(o, vb0 + (int)SHM_V, vf, pa0, pa1, pa2, pa3); else pv_d0(o, vb0 + (int)SHM_V, pa0, pa1, pa2, pa3);
        partialSM<DQK, MODE>(pA0, pA1, m_reg, mnA, alA);
        __syncthreads(); SWAIT(); SWRITE(1, SO);
        RESC(alA); __syncthreads();
    }
    if constexpr ((KPF & 4) != 0) __builtin_amdgcn_s_setprio(0);
    SBAR(); qkt<DQK, KPF>(pB0, pB1, K_lds + SHM_K, KR_lds + SHM_KR, QR_lds, qr, r32, hi, qrow);
    finishSM(pA0, pA1, alA, l_reg, pa0, pa1, pa2, pa3); SBAR();
    pv_d0(o, vb0, pa0, pa1, pa2, pa3); partialSM<DQK, MODE>(pB0, pB1, m_reg, mnB, alB);
    __syncthreads(); RESC(alB);
    finishSM(pB0, pB1, alB, l_reg, pa0, pa1, pa2, pa3); SBAR();
    pv_d0(o, vb0 + (int)SHM_V, pa0, pa1, pa2, pa3);
    }
    volatile int* badflag = (volatile int*)(lds + LDS_MISC + 200);
    if (MODE == 2) { const bool bad = !(l_reg > 0.f && l_reg < 1e30f); if (__any(bad) && lane == 0) *badflag = 1; }
    if (hi == 0) li_l[r32] = l_reg; asm volatile("s_waitcnt lgkmcnt(0)" ::: "memory");
    float rli[16];
#pragma unroll
    for (int r = 0; r < 16; ++r) rli[r] = __builtin_amdgcn_rcpf(li_l[crow(r, hi)]);
    bf16* Ow = Ob + (long)(wid * QBLK) * LDO;
#pragma unroll
    for (int r = 0; r < 16; ++r) { const int orow = crow(r, hi);
#pragma unroll
        for (int d0 = 0; d0 < 4; ++d0) Ow[(long)orow * LDO + d0 * 32 + r32] = f2bf(o[d0][r] * rli[r]); }
    __syncthreads();
    bool ok = true;
    if (MODE == 2) { ok = (*badflag == 0); __syncthreads(); if (tid == 0) *badflag = 0; }
#undef SLOAD
#undef SWRITE
#undef SWAIT
#undef RESC
    return ok;
}

}

struct Ctx {
    float* out; unsigned char* ws;
    int G, blk;
};
#define PHASE_IDS() const int tid = opaque_tid(); const int lane = tid & 63; const int wave = __builtin_amdgcn_readfirstlane(tid >> 6); (void)lane; (void)wave
__device__ __forceinline__ const float* cin(int i) {
    const __attribute__((address_space(4))) char* kp = (const __attribute__((address_space(4))) char*)__builtin_amdgcn_kernarg_segment_ptr();
    asm volatile("" : "+s"(kp));
    return *(const float* const __attribute__((address_space(4)))*)(kp + 8 * i);
}
#define CIN(i) cin(i)
#define IN_X 0
#define IN_C 1
#define IN_CTX 2
#define IN_CCTX 3
#define IN_WMOD 4
#define IN_BMOD 5
#define IN_WIN 6
#define IN_CONVW 7
#define IN_CONVB 8
#define IN_GATEB 9
#define IN_ANORM 10
#define IN_BQN 11
#define IN_BKN 12
#define IN_CQN 13
#define IN_WUQ 14
#define IN_CKVN 15
#define IN_WUKV 16
#define IN_WOUT 17
#define IN_LN1G 18
#define IN_LN1B 19
#define IN_LN2G 20
#define IN_LN2B 21
#define IN_WRG 22
#define IN_BRG 23
#define IN_WRE 24
#define IN_BRE 25
#define IN_EGATE 26
#define IN_EUP 27
#define IN_EDOWN 28
#define WSP(T_, off) ((T_*)(C.ws + (off)))

__device__ __forceinline__ void unpack8(const u32x4 w, float (&f)[8]) { f[0] = bflo(w.x); f[1] = bfhi(w.x); f[2] = bflo(w.y); f[3] = bfhi(w.y); f[4] = bflo(w.z); f[5] = bfhi(w.z); f[6] = bflo(w.w); f[7] = bfhi(w.w); }
__device__ __forceinline__ u32x4 pack8(const float (&f)[8]) { u32x4 w; w.x = cvtpk(f[0], f[1]); w.y = cvtpk(f[2], f[3]); w.z = cvtpk(f[4], f[5]); w.w = cvtpk(f[6], f[7]); return w; }
template <class RM>
__device__ __forceinline__ void transpose_item(const float* __restrict__ W, int K, int N, bf16* __restrict__ WT, float* scr, int item, int lane, RM rowmap) {
    const int nblk = (N + 31) >> 5, kb = item / nblk, nb = item - kb * nblk, k0 = 64 * kb, n0 = 32 * nb;
    const int c4 = (lane & 7) * 4, r8 = lane >> 3; const bool ok = n0 + c4 < N;
    f32x4 v[8];
#pragma unroll
    for (int i = 0; i < 8; ++i) v[i] = ok ? *(const f32x4*)(W + (size_t)(k0 + r8 + 8 * i) * N + n0 + c4) : (f32x4){0.f, 0.f, 0.f, 0.f};
#pragma unroll
    for (int i = 0; i < 8; ++i) { float* d = scr + (r8 + 8 * i) * 33 + c4; d[0] = v[i][0]; d[1] = v[i][1]; d[2] = v[i][2]; d[3] = v[i][3]; }
    LDS_WAIT(); asm volatile("" ::: "memory");
    const int c = lane & 7;
#pragma unroll
    for (int j = 0; j < 4; ++j) { const int n = (lane >> 3) + 8 * j;
        if (n0 + n < N) { const float* s = scr + (8 * c) * 33 + n;
            u32x4 o; o.x = cvtpk(s[0 * 33], s[1 * 33]); o.y = cvtpk(s[2 * 33], s[3 * 33]); o.z = cvtpk(s[4 * 33], s[5 * 33]); o.w = cvtpk(s[6 * 33], s[7 * 33]);
            *(u32x4*)(WT + (size_t)rowmap(n0 + n) * K + k0 + 8 * c) = o; } }
    LDS_WAIT(); asm volatile("" ::: "memory");
}
struct RmId { __device__ int operator()(int c) const { return c; } };
struct RmWin { __device__ int operator()(int c) const {
    if (c < 512) return ZMQ + c; if (c < 1024) return ZMV + (c - 512); if (c < 1040) return ZGATE + (c - 1024); if (c < 1552) return ZOG + (c - 1040);
    if (c < 3088) return c - 1552; return ZCQ + (c - 3088); } };
struct RmUq { __device__ int operator()(int c) const { const int h = c / 192, r = c - h * 192;
    if (r < 128) return (h >> 1) * 256 + (h & 1) * 128 + r; const int rr = r - 128; return (rr < 32) ? (512 + 32 * h + rr) : (640 + 32 * h + (rr - 32)); } };
struct RmGate { int add; __device__ int operator()(int c) const { return ((c >> 7) << 8) + (c & 127) + add; } };

static_assert((size_t)NEXP * 1024 * D * 2 + (size_t)NEXP * D * DEXP * 2 <= (size_t)NL * D * 4, "layer-1 expert weights fit d_out");
__device__ __forceinline__ bf16* wgu_base(const Ctx& C, int l) { (void)l; return WSP(bf16, WS_WGU); }
__device__ __forceinline__ bf16* wd_base(const Ctx& C, int l) { (void)l; return WSP(bf16, WS_WD); }
__device__ __forceinline__ void expert_item(const Ctx& C, int l, int it, float* scr, int lane) {
    const int e = it / 1536, r = it - e * 1536;
    bf16* wgu = wgu_base(C, l) + (size_t)e * 1024 * D; bf16* wd = wd_base(C, l) + (size_t)e * D * DEXP;
    const size_t eo = ((size_t)l * NEXP + e) * (size_t)D * DEXP;
    if (r < 512) transpose_item(CIN(IN_EGATE) + eo, D, DEXP, wgu, scr, r, lane, RmGate{0});
    else if (r < 1024) transpose_item(CIN(IN_EUP) + eo, D, DEXP, wgu, scr, r - 512, lane, RmGate{128});
    else transpose_item(CIN(IN_EDOWN) + eo, DEXP, D, wd, scr, r - 1024, lane, RmId{});
}
constexpr int IT_EXP = NEXP * 1536;
__device__ __forceinline__ void fill_finish(const Ctx& C, char* lds, int l, int b0, int nb) {
    PHASE_IDS(); float* scr = (float*)lds + wave * (64 * 33);
    for (int it = (C.blk - b0) * NWAVES + wave; it < IT_EXP; it += nb * NWAVES) expert_item(C, l, it, scr, lane);
}
constexpr int IT_WIN = 32 * 123, IT_WOUT = 32 * 64, IT_UQ = 8 * 24, IT_UKV = 4 * 32, IT_LAYER = IT_WIN + IT_WOUT + IT_UQ + IT_UKV;

__device__ __forceinline__ void phase_pre0(const Ctx& C, char* lds) {
    PHASE_IDS();
    float* sc = (float*)lds;
    float* part = sc + 3 * 2048;
    for (int item = C.blk; item < 192; item += C.G) {
        const int l = item / 96, j0 = (item % 96) * 128;
        for (int i = tid; i < 3 * 2048; i += NTHREADS) { const int s = i >> 11, k = i & 2047; const float v = (s < 2) ? CIN(IN_C)[s * 2048 + k] : CIN(IN_CCTX)[k]; sc[i] = v / (1.f + __expf(-v)); }
        __syncthreads();
        const int ks = tid >> 5, cq = tid & 31;
        const float* wp = CIN(IN_WMOD) + (size_t)l * D * 12288 + (size_t)(ks * 128) * 12288 + j0 + cq * 4;
        f32x4 a0 = {0, 0, 0, 0}, a1 = a0, a2 = a0;
#pragma unroll 8
        for (int k = 0; k < 128; ++k) { const f32x4 w = *(const f32x4*)(wp + (size_t)k * 12288);
            a0 += w * sc[ks * 128 + k]; a1 += w * sc[2048 + ks * 128 + k]; a2 += w * sc[4096 + ks * 128 + k]; }
        *(f32x4*)(part + (ks * 3 + 0) * 128 + cq * 4) = a0; *(f32x4*)(part + (ks * 3 + 1) * 128 + cq * 4) = a1; *(f32x4*)(part + (ks * 3 + 2) * 128 + cq * 4) = a2;
        __syncthreads();
        if (tid < 384) { const int s = tid >> 7, j = tid & 127; float a = CIN(IN_BMOD)[l * 12288 + j0 + j];
#pragma unroll
            for (int q = 0; q < 16; ++q) a += part[(q * 3 + s) * 128 + j];
            WSP(float, WS_MOD)[(size_t)(l * 3 + s) * 12288 + j0 + j] = a; }
        __syncthreads();
    }
    { float* rp = WSP(float, WS_ROPE);
      for (int g = C.blk * NTHREADS + tid; g < 9216; g += C.G * NTHREADS) {
          int nf, p, f; float* base;
          if (g < 6144) { nf = 32; p = g >> 5; f = g & 31; base = rp; } else { nf = 16; const int q = g - 6144; p = q >> 4; f = q & 15; base = rp + 12288; }
          const float inv = powf(10000.f, -(float)f / (float)nf);
          const int pos = p < 128 ? p : p - 128; const float ang = (float)pos * inv;
          float* ct = (p < 128) ? (base + p * nf + f) : (base + 2 * 128 * nf + (p - 128) * nf + f);
          float* st = ct + ((p < 128) ? 128 * nf : 64 * nf);
          *ct = cosf(ang); *st = sinf(ang); } }
    { bf16* w = WSP(bf16, WS_WIN);
      const int nz = 2 * (ZW - INW) * (D / 8);
      for (int g = C.blk * NTHREADS + tid; g < nz; g += C.G * NTHREADS) { const int l = g / ((ZW - INW) * (D / 8)), r = g % ((ZW - INW) * (D / 8));
          *(u32x4*)(w + ((size_t)l * ZW + INW) * D + (size_t)r * 8) = (u32x4){0u, 0u, 0u, 0u}; } }
    { bf16* wrt = WSP(bf16, WS_WRT); const float* wrg = CIN(IN_WRG); const float* wre = CIN(IN_WRE);
      for (int g = C.blk * NTHREADS + tid; g < 2 * 32 * (D / 8); g += C.G * NTHREADS) { const int l = g / (32 * (D / 8)), r = g % (32 * (D / 8)), c = r / (D / 8), k0 = (r % (D / 8)) * 8;
          float hi8[8], lo8[8];
#pragma unroll
          for (int e = 0; e < 8; ++e) { const int k = k0 + e; const float w = (c < 4) ? wrg[((size_t)l * D + k) * 4 + c] : ((c < 20) ? wre[((size_t)l * D + k) * 16 + (c - 4)] : 0.f);
              const float h = bf2f(f2bf(w)); hi8[e] = h; lo8[e] = w - h; }
          *(u32x4*)(wrt + ((size_t)(l * 2 + 0) * 32 + c) * D + k0) = pack8(hi8); *(u32x4*)(wrt + ((size_t)(l * 2 + 1) * 32 + c) * D + k0) = pack8(lo8); } }
    float* scr = (float*)lds + wave * (64 * 33);
    const int gw = C.blk * NWAVES + wave, NGW = C.G * NWAVES;
    for (int it = gw; it < 2 * IT_LAYER; it += NGW) {
        { const int l = it / IT_LAYER; int r = it - l * IT_LAYER;
            if (r < IT_WIN) { transpose_item(CIN(IN_WIN) + (size_t)l * D * INW, D, INW, WSP(bf16, WS_WIN) + (size_t)l * ZW * D, scr, r, lane, RmWin{}); continue; } r -= IT_WIN;
            if (r < IT_WOUT) { transpose_item(CIN(IN_WOUT) + (size_t)l * D * D, D, D, WSP(bf16, WS_WOUT) + (size_t)l * D * D, scr, r, lane, RmId{}); continue; } r -= IT_WOUT;
            if (r < IT_UQ) { transpose_item(CIN(IN_WUQ) + (size_t)l * 512 * 768, 512, 768, WSP(bf16, WS_WUQ) + (size_t)l * 768 * 512, scr, r, lane, RmUq{}); continue; } r -= IT_UQ;
            transpose_item(CIN(IN_WUKV) + (size_t)l * 256 * 1024, 256, 1024, WSP(bf16, WS_WUKV) + (size_t)l * 1024 * 256, scr, r, lane, RmId{});
        }
    }
}

__device__ __forceinline__ const float* x0_row(const float* x, const float* cx, int n) { return (n < NL) ? x + (size_t)n * D : cx + (size_t)(n - NL) * D; }
__device__ __forceinline__ int mod_set(int n) { return (n < NL) ? (n >> 13) : 2; }

__device__ __forceinline__ void phase_pre1(const Ctx& C) {
    PHASE_IDS();
    const int gw = C.blk * NWAVES + wave, NGW = C.G * NWAVES;
    const float* px = CIN(IN_X); const float* pcx = CIN(IN_CTX);
    for (int n = gw; n < M; n += NGW) {
        const int lane = opaque_tid() & 63;
        const float* xr = x0_row(px, pcx, n); const float* md = WSP(float, WS_MOD) + (size_t)mod_set(n) * 12288;
        bf16* hr = WSP(bf16, WS_HB) + (size_t)n * D;
#pragma unroll
        for (int j = 0; j < 4; ++j) { const int k = (lane + 64 * j) * 8;
            const f32x4 x0 = *(const f32x4*)(xr + k), x1 = *(const f32x4*)(xr + k + 4);
            const f32x4 s0 = *(const f32x4*)(md + 2048 + k), s1 = *(const f32x4*)(md + 2048 + k + 4), h0 = *(const f32x4*)(md + k), h1 = *(const f32x4*)(md + k + 4);
            const f32x4 a = x0 * (s0 + 1.f) + h0, b = x1 * (s1 + 1.f) + h1;
            u32x4 w; w.x = cvtpk(a[0], a[1]); w.y = cvtpk(a[2], a[3]); w.z = cvtpk(b[0], b[1]); w.w = cvtpk(b[2], b[3]);
            *(u32x4*)(hr + k) = w; }
    }
}


__device__ __forceinline__ void ld8f(const float* p, float (&f)[8]) { const f32x4 a = *(const f32x4*)p, b = *(const f32x4*)(p + 4); f[0] = a[0]; f[1] = a[1]; f[2] = a[2]; f[3] = a[3]; f[4] = b[0]; f[5] = b[1]; f[6] = b[2]; f[7] = b[3]; }
struct PostRaw { u32x4 q0, q1, kA, kB, cq, cA, cB; };
struct PostGains { float q0[8], q1[8], k0[8], k1[8], cq[8], ck[8]; };
__device__ __forceinline__ void post_load(const Ctx& C, int n, int lane, PostRaw& R) {
    const bf16* zr = WSP(bf16, WS_Z) + (size_t)n * ZW;
    const int h = lane >> 3, sub = lane & 7;
    R.q0 = *(const u32x4*)(zr + ZQG + h * 128 + sub * 8); R.q1 = *(const u32x4*)(zr + ZQG + h * 128 + 64 + sub * 8);
    const int ka = (lane < 16) ? (ZKG + h * 128 + sub * 8) : ((lane < 48) ? (ZVG + (lane - 16) * 8) : ZKG);
    R.kA = *(const u32x4*)(zr + ka); R.kB = *(const u32x4*)(zr + ((lane < 16) ? ka + 64 : ka));
    R.cq = *(const u32x4*)(zr + ZCQ + lane * 8);
    const int ca = (lane < 32) ? (ZCKV + lane * 8) : ((lane < 36) ? (ZKR + (lane - 32) * 8) : ZCKV);
    R.cA = *(const u32x4*)(zr + ca); R.cB = *(const u32x4*)(zr + ((lane >= 32 && lane < 36) ? ca + 32 : ca));
}
__device__ __forceinline__ void post_row(const Ctx& C, const PostGains& G, const PostRaw& R, int n, int lane) {
    const bool lat = n < NL;
#ifdef PROBE_NOROPE
    const bool dorope = false;
#else
    const bool dorope = lat;
#endif
    int b, pos, prow = 0, pcol = 0;
    if (lat) { b = n >> 13; const int t = n & (T - 1); pos = CTXL + t; prow = t >> 6; pcol = t & 63; } else { b = (n - NL) >> 8; pos = (n - NL) & 255; }
    const float* rpB = WSP(float, WS_ROPE); const float* rpC = rpB + 12288;
    const int h = lane >> 3, sub = lane & 7;
    float ct[8], st[8], c2[8], s2[8];
    { const float* ctp = (sub < 4) ? (rpB + prow * 32 + sub * 8) : (rpB + 8192 + pcol * 32 + (sub - 4) * 8); ld8f(ctp, ct); ld8f(ctp + ((sub < 4) ? 4096 : 2048), st);
      const int s4 = lane & 3; const float* ckp = (s4 < 2) ? (rpC + prow * 16 + s4 * 8) : (rpC + 4096 + pcol * 16 + (s4 - 2) * 8); ld8f(ckp, c2); ld8f(ckp + ((s4 < 2) ? 2048 : 1024), s2); }
    { float x1[8], x2[8]; unpack8(R.q0, x1); unpack8(R.q1, x2);
      float ss = 0.f;
#pragma unroll
      for (int e = 0; e < 8; ++e) ss += x1[e] * x1[e] + x2[e] * x2[e];
      ss += __shfl_xor(ss, 1); ss += __shfl_xor(ss, 2); ss += __shfl_xor(ss, 4);
      const float rinv = rsqrtf(ss * (1.f / 128.f) + RMS_EPS);
      float o1[8], o2[8];
      const float qs = rinv * 0.12751743f;
#pragma unroll
      for (int e = 0; e < 8; ++e) { const float a = x1[e] * qs * G.q0[e], c = x2[e] * qs * G.q1[e];
          o1[e] = dorope ? a * ct[e] - c * st[e] : a; o2[e] = dorope ? c * ct[e] + a * st[e] : c; }
      bf16* dst = WSP(bf16, WS_QG) + (size_t)n * 1024 + h * 128 + sub * 8;
      *(u32x4*)dst = pack8(o1); *(u32x4*)(dst + 64) = pack8(o2); }
    { float x1[8], x2[8]; unpack8(R.kA, x1); unpack8(R.kB, x2);
      float ss = 0.f;
#pragma unroll
      for (int e = 0; e < 8; ++e) ss += x1[e] * x1[e] + x2[e] * x2[e];
      ss += __shfl_xor(ss, 1); ss += __shfl_xor(ss, 2); ss += __shfl_xor(ss, 4);
      const float rinv = rsqrtf(ss * (1.f / 128.f) + RMS_EPS);
      float o1[8], o2[8];
#pragma unroll
      for (int e = 0; e < 8; ++e) { const float a = x1[e] * rinv * G.k0[e], c = x2[e] * rinv * G.k1[e];
          o1[e] = dorope ? a * ct[e] - c * st[e] : a; o2[e] = dorope ? c * ct[e] + a * st[e] : c; }
      if (lane < 16) { bf16* dst = WSP(bf16, WS_KG) + ((size_t)(b * 2 + h) * SKV + pos) * 128 + sub * 8;
          *(u32x4*)dst = pack8(o1); *(u32x4*)(dst + 64) = pack8(o2); }
      else if (lane < 48) { const int c = lane - 16;
          *(u32x4*)(WSP(bf16, WS_VG) + ((size_t)(b * 2 + (c >> 4)) * SKV + pos) * 128 + (c & 15) * 8) = R.kA; } }
    { float f[8]; unpack8(R.cq, f);
      float ss = 0.f;
#pragma unroll
      for (int e = 0; e < 8; ++e) ss += f[e] * f[e];
      ss = wave_sum(ss);
      const float rinv = rsqrtf(ss * (1.f / 512.f) + RMS_EPS);
#pragma unroll
      for (int e = 0; e < 8; ++e) f[e] = f[e] * rinv * G.cq[e];
      *(u32x4*)(WSP(bf16, WS_CQ) + (size_t)n * 512 + lane * 8) = pack8(f); }
    { float x1[8], x2[8]; unpack8(R.cA, x1); unpack8(R.cB, x2);
      float ss = 0.f;
#pragma unroll
      for (int e = 0; e < 8; ++e) ss += x1[e] * x1[e];
      ss = (lane < 32) ? ss : 0.f;
      ss += __shfl_xor(ss, 1); ss += __shfl_xor(ss, 2); ss += __shfl_xor(ss, 4); ss += __shfl_xor(ss, 8); ss += __shfl_xor(ss, 16);
      const float rinv = rsqrtf(ss * (1.f / 256.f) + RMS_EPS);
      if (lane < 32) { float f[8];
#pragma unroll
          for (int e = 0; e < 8; ++e) f[e] = x1[e] * rinv * G.ck[e];
          *(u32x4*)(WSP(bf16, WS_CKV) + (size_t)n * 256 + lane * 8) = pack8(f); }
      else if (lane < 36) { const int s4 = lane - 32;
          float o1[8], o2[8];
#pragma unroll
          for (int e = 0; e < 8; ++e) { o1[e] = dorope ? x1[e] * c2[e] - x2[e] * s2[e] : x1[e]; o2[e] = dorope ? x2[e] * c2[e] + x1[e] * s2[e] : x2[e]; }
          const u32x4 w1 = pack8(o1), w2 = pack8(o2);
#pragma unroll
          for (int hh = 0; hh < 4; ++hh) { bf16* dst = WSP(bf16, WS_KM) + ((size_t)(b * 4 + hh) * SKV + pos) * 192 + 128 + s4 * 8; *(u32x4*)dst = w1; *(u32x4*)(dst + 32) = w2; } } }
}
__device__ __forceinline__ void post_rows(const Ctx& C, int l) {
    PHASE_IDS();
    const int NGW = C.G * NWAVES;
    PostGains G;
    { const int sub = lane & 7; const float* bqn = CIN(IN_BQN) + l * 128; const float* bkn = CIN(IN_BKN) + l * 128;
      ld8f(bqn + sub * 8, G.q0); ld8f(bqn + 64 + sub * 8, G.q1); ld8f(bkn + sub * 8, G.k0); ld8f(bkn + 64 + sub * 8, G.k1);
      ld8f(CIN(IN_CQN) + l * 512 + lane * 8, G.cq); ld8f(CIN(IN_CKVN) + l * 256 + (lane & 31) * 8, G.ck); }
    int n = C.blk * NWAVES + wave;
    PostRaw cur; if (n < M) post_load(C, n, lane, cur);
    for (; n < M; n += NGW) {
        PostRaw nxt = cur; if (n + NGW < M) post_load(C, n + NGW, lane, nxt);
        post_row(C, G, cur, n, lane);
        cur = nxt;
    }
}

__device__ __forceinline__ void conv_silu16(const Ctx& C, int l, int row, int lo, int hi, int zcol, int cw, float scale, float (&o)[16]) {
    const bf16* z = WSP(bf16, WS_Z);
    const float* w = CIN(IN_CONVW) + (size_t)l * 3 * 512 + cw; const float* bb = CIN(IN_CONVB) + l * 512 + cw;
    float a[16], p[16], q[16];
    { const bf16* r = z + (size_t)row * ZW + zcol; float t0[8], t1[8]; unpack8(*(const u32x4*)r, t0); unpack8(*(const u32x4*)(r + 8), t1);
#pragma unroll
      for (int e = 0; e < 8; ++e) { a[e] = t0[e]; a[8 + e] = t1[e]; } }
    if (row - 1 >= lo) { const bf16* r = z + (size_t)(row - 1) * ZW + zcol; float t0[8], t1[8]; unpack8(*(const u32x4*)r, t0); unpack8(*(const u32x4*)(r + 8), t1);
#pragma unroll
      for (int e = 0; e < 8; ++e) { p[e] = t0[e]; p[8 + e] = t1[e]; } }
    else {
#pragma unroll
      for (int e = 0; e < 16; ++e) p[e] = 0.f; }
    if (row + 1 < hi) { const bf16* r = z + (size_t)(row + 1) * ZW + zcol; float t0[8], t1[8]; unpack8(*(const u32x4*)r, t0); unpack8(*(const u32x4*)(r + 8), t1);
#pragma unroll
      for (int e = 0; e < 8; ++e) { q[e] = t0[e]; q[8 + e] = t1[e]; } }
    else {
#pragma unroll
      for (int e = 0; e < 16; ++e) q[e] = 0.f; }
    float w0[16], w1[16], w2[16], b0[16];
#pragma unroll
    for (int e = 0; e < 16; e += 4) { const f32x4 t0 = *(const f32x4*)(w + e), t1 = *(const f32x4*)(w + 512 + e), t2 = *(const f32x4*)(w + 1024 + e), t3 = *(const f32x4*)(bb + e);
#pragma unroll
        for (int q4 = 0; q4 < 4; ++q4) { w0[e + q4] = t0[q4]; w1[e + q4] = t1[q4]; w2[e + q4] = t2[q4]; b0[e + q4] = t3[q4]; } }
#pragma unroll
    for (int e = 0; e < 16; ++e) { const float v = w0[e] * p[e] + w1[e] * a[e] + w2[e] * q[e] + b0[e]; o[e] = siluf_(v) * scale; }
}
__device__ __forceinline__ void chunk_geom(int b, int cp, int& row0, int& lo, int& hi) {
    if (cp < 2) { lo = NL + b * CTXL; hi = lo + CTXL; row0 = lo + cp * 128; } else { lo = b * T; hi = lo + T; row0 = lo + (cp - 2) * 128; }
}
__device__ __forceinline__ int scan_index(int cp, int d) { return d == 0 ? cp : (cp < 2 ? 1 - cp : 67 - cp); }
__device__ __forceinline__ void stage_gates(const Ctx& C, int l, int row0, int h, float* gi, float* glf, int tid) {
    if (tid < 128) { const bf16* r = WSP(bf16, WS_Z) + (size_t)(row0 + tid) * ZW + ZGATE;
        float t0[8], t1[8]; unpack8(*(const u32x4*)r, t0); unpack8(*(const u32x4*)(r + 8), t1);
        float g[16];
#pragma unroll
        for (int e = 0; e < 8; ++e) { g[e] = t0[e]; g[8 + e] = t1[e]; }
        float v0 = 0, v1 = 0, v2 = 0, v3 = 0;
#pragma unroll
        for (int hh = 0; hh < 4; ++hh) if (hh == h) { v0 = g[hh]; v1 = g[4 + hh]; v2 = g[8 + hh]; v3 = g[12 + hh]; }
        const float* gb = CIN(IN_GATEB) + l * 16;
        gi[tid] = v0 + gb[h]; gi[128 + tid] = v1 + gb[4 + h];
        glf[tid] = logsigmoidf_(v2 + gb[8 + h]); glf[128 + tid] = logsigmoidf_(v3 + gb[12 + h]); }
}
template <bool WITH_R>
__device__ __forceinline__ void gate_scan(int d, int lane, const float* gi, const float* glf, float* bc, float* uu, float* rr, float mprev, float& umax, float& blast) {
    const int p0 = d ? 127 - 2 * lane : 2 * lane, p1 = d ? 126 - 2 * lane : 2 * lane + 1;
    const float x0 = glf[d * 128 + p0], x1 = glf[d * 128 + p1];
    float inc = x0 + x1;
#pragma unroll
    for (int o = 1; o < 64; o <<= 1) { const float t = __shfl_up(inc, o); if (lane >= o) inc += t; }
    const float b1 = inc, b0 = inc - x1;
    const float u0 = gi[d * 128 + p0] - b0, u1 = gi[d * 128 + p1] - b1;
    bc[d * 128 + p0] = b0; bc[d * 128 + p1] = b1; uu[d * 128 + p0] = u0; uu[d * 128 + p1] = u1;
    float mx = fmaxf(u0, u1);
    if (WITH_R) { float cm = mx;
#pragma unroll
        for (int o = 1; o < 64; o <<= 1) { const float t = __shfl_up(cm, o); if (lane >= o) cm = fmaxf(cm, t); }
        float ex = __shfl_up(cm, 1); if (lane == 0) ex = -3.0e38f;
        const float r0 = fmaxf(mprev, fmaxf(ex, u0)), r1 = fmaxf(mprev, cm);
        rr[d * 128 + p0] = r0; rr[d * 128 + p1] = r1; }
#pragma unroll
    for (int o = 1; o < 64; o <<= 1) mx = fmaxf(mx, __shfl_xor(mx, o));
    umax = mx; blast = __shfl(b1, 63);
}

constexpr int ML_CW_OFF = 114688;
struct MlHead { u32x4 g0, g1, qa0, qa1, qp0, qp1, qq0, qq1, ka0, ka1, kp0, kp1, kq0, kq1, v0, v1, v2, v3; float cw, gb0, gb1, gb2, gb3; bool okp, okq; };
template <bool WITHQ>
__device__ __forceinline__ void ml_head_load(const Ctx& C, int l, int row0, int lo, int hi, int h, int tid, MlHead& H) {
    const bf16* z = WSP(bf16, WS_Z);
    const int pos = tid >> 2, part = tid & 3, row = row0 + pos;
    H.okp = row - 1 >= lo; H.okq = row + 1 < hi;
    const bf16* za = z + (size_t)row * ZW; const bf16* zp = z + (size_t)(H.okp ? row - 1 : row) * ZW; const bf16* zq = z + (size_t)(H.okq ? row + 1 : row) * ZW;
    const bf16* gr = z + (size_t)(row0 + (tid & 127)) * ZW + ZGATE;
    const int ck = ZMK + h * 64 + part * 16, cq = ZMQ + h * 64 + part * 16, cv = ZMV + h * 128 + part * 32;
    const int sec = tid >> 6, c = tid & 63;
    const float* cwp = (sec < 6) ? (CIN(IN_CONVW) + (size_t)l * 3 * 512 + (sec % 3) * 512 + (sec >= 3 ? 256 : 0) + h * 64 + c) : (CIN(IN_CONVB) + l * 512 + (sec == 7 ? 256 : 0) + h * 64 + c);
    const float* gb = CIN(IN_GATEB) + l * 16 + h;
    H.g0 = *(const u32x4*)gr; H.g1 = *(const u32x4*)(gr + 8);
    H.ka0 = *(const u32x4*)(za + ck); H.ka1 = *(const u32x4*)(za + ck + 8); H.kp0 = *(const u32x4*)(zp + ck); H.kp1 = *(const u32x4*)(zp + ck + 8); H.kq0 = *(const u32x4*)(zq + ck); H.kq1 = *(const u32x4*)(zq + ck + 8);
    if constexpr (WITHQ) { H.qa0 = *(const u32x4*)(za + cq); H.qa1 = *(const u32x4*)(za + cq + 8); H.qp0 = *(const u32x4*)(zp + cq); H.qp1 = *(const u32x4*)(zp + cq + 8); H.qq0 = *(const u32x4*)(zq + cq); H.qq1 = *(const u32x4*)(zq + cq + 8); }
    H.v0 = *(const u32x4*)(za + cv); H.v1 = *(const u32x4*)(za + cv + 8); H.v2 = *(const u32x4*)(za + cv + 16); H.v3 = *(const u32x4*)(za + cv + 24);
    H.cw = *cwp; H.gb0 = gb[0]; H.gb1 = gb[4]; H.gb2 = gb[8]; H.gb3 = gb[12];
    SBAR();
}
__device__ __forceinline__ void ml_head_stage(const MlHead& H, int h, int tid, float* gi, float* glf, float* cwl) {
    cwl[tid] = H.cw;
    if (tid < 128) { float t0[8], t1[8]; unpack8(H.g0, t0); unpack8(H.g1, t1);
        float g[16];
#pragma unroll
        for (int e = 0; e < 8; ++e) { g[e] = t0[e]; g[8 + e] = t1[e]; }
        float v0 = 0, v1 = 0, v2 = 0, v3 = 0;
#pragma unroll
        for (int hh = 0; hh < 4; ++hh) if (hh == h) { v0 = g[hh]; v1 = g[4 + hh]; v2 = g[8 + hh]; v3 = g[12 + hh]; }
        gi[tid] = v0 + H.gb0; gi[128 + tid] = v1 + H.gb1;
        glf[tid] = logsigmoidf_(v2 + H.gb2); glf[128 + tid] = logsigmoidf_(v3 + H.gb3); }
}
__device__ __forceinline__ void ml_conv16(const u32x4 a0, const u32x4 a1, const u32x4 p0, const u32x4 p1, const u32x4 q0, const u32x4 q1, bool okp, bool okq, const float* cwl, int sel, int part, float scale, float (&o)[16]) {
    float a[16], p[16], q[16];
    { float t0[8], t1[8]; unpack8(a0, t0); unpack8(a1, t1);
#pragma unroll
      for (int e = 0; e < 8; ++e) { a[e] = t0[e]; a[8 + e] = t1[e]; } }
    { float t0[8], t1[8]; unpack8(p0, t0); unpack8(p1, t1);
#pragma unroll
      for (int e = 0; e < 8; ++e) { p[e] = okp ? t0[e] : 0.f; p[8 + e] = okp ? t1[e] : 0.f; } }
    { float t0[8], t1[8]; unpack8(q0, t0); unpack8(q1, t1);
#pragma unroll
      for (int e = 0; e < 8; ++e) { q[e] = okq ? t0[e] : 0.f; q[8 + e] = okq ? t1[e] : 0.f; } }
    const float* w = cwl + sel * 192 + part * 16; const float* bb = cwl + (6 + sel) * 64 + part * 16;
#pragma unroll
    for (int e = 0; e < 16; e += 4) { const f32x4 t0 = *(const f32x4*)(w + e), t1 = *(const f32x4*)(w + 64 + e), t2 = *(const f32x4*)(w + 128 + e), t3 = *(const f32x4*)(bb + e);
#pragma unroll
        for (int q4 = 0; q4 < 4; ++q4) { const float v = t0[q4] * p[e + q4] + t1[q4] * a[e + q4] + t2[q4] * q[e + q4] + t3[q4]; o[e + q4] = siluf_(v) * scale; } }
}
__device__ __forceinline__ void ml_vscatter(const MlHead& H, bf16* vt, int pos, int part) {
    const u32x4 vv[4] = {H.v0, H.v1, H.v2, H.v3};
#pragma unroll
    for (int q = 0; q < 4; ++q) { const unsigned ww[4] = {vv[q].x, vv[q].y, vv[q].z, vv[q].w};
#pragma unroll
        for (int e = 0; e < 4; ++e) { vt[(part * 32 + q * 8 + 2 * e) * 136 + pos] = (bf16)(ww[e] & 0xffffu); vt[(part * 32 + q * 8 + 2 * e + 1) * 136 + pos] = (bf16)(ww[e] >> 16); } }
}
__device__ __forceinline__ void mlstm_a_unit(const Ctx& C, int l, int unit, char* lds) {
    const int b = unit / (4 * NCHUNK), h = (unit / NCHUNK) & 3, cp = unit % NCHUNK;
    int row0, lo, hi; chunk_geom(b, cp, row0, lo, hi);
    float* kk = (float*)lds;
    bf16* ktw = (bf16*)(lds + 32768);
    bf16* vt = (bf16*)(lds + 32768 + 34816);
    float* gi = (float*)(lds + 32768 + 2 * 34816);
    float* glf = gi + 256; float* bc = glf + 256; float* uu = bc + 256; float* wj = uu + 256; float* red = wj + 256;
    const int tid = opaque_tid(), lane = tid & 63, wid = __builtin_amdgcn_readfirstlane(tid >> 6);
    float* cwl = (float*)(lds + ML_CW_OFF);
    { MlHead H; ml_head_load<false>(C, l, row0, lo, hi, h, tid, H);
      ml_head_stage(H, h, tid, gi, glf, cwl);
      const int pos = tid >> 2, part = tid & 3;
      ml_vscatter(H, vt, pos, part);
      __syncthreads();
      float o[16];
      ml_conv16(H.ka0, H.ka1, H.kp0, H.kp1, H.kq0, H.kq1, H.okp, H.okq, cwl, 1, part, 0.125f, o);
#pragma unroll
      for (int e = 0; e < 16; e += 4) *(f32x4*)(kk + pos * 64 + part * 16 + e) = (f32x4){o[e], o[e + 1], o[e + 2], o[e + 3]}; }
    __syncthreads();
    if (wid < 2) { const int d = wid; float umax, blast;
        gate_scan<false>(d, lane, gi, glf, bc, uu, nullptr, 0.f, umax, blast);
        LDS_WAIT();
        wj[d * 128 + 2 * lane] = __expf(uu[d * 128 + 2 * lane] - umax); wj[d * 128 + 2 * lane + 1] = __expf(uu[d * 128 + 2 * lane + 1] - umax);
        if (lane == 0) { float* st = WSP(float, WS_USTAT) + ((size_t)((b * 4 + h) * 2 + d) * NCHUNK + scan_index(cp, d)) * 2; st[0] = umax; st[1] = blast; } }
    __syncthreads();
    { const int dk = tid & 63, pg = tid >> 6;
#pragma unroll
      for (int d = 0; d < 2; ++d) { float v[16]; float pn = 0.f;
#pragma unroll
          for (int e = 0; e < 16; ++e) { v[e] = wj[d * 128 + pg * 16 + e] * kk[(pg * 16 + e) * 64 + dk]; pn += v[e]; }
          bf16* dst = ktw + d * (64 * 136) + dk * 136 + pg * 16;
          u32x4 w0, w1; w0.x = cvtpk(v[0], v[1]); w0.y = cvtpk(v[2], v[3]); w0.z = cvtpk(v[4], v[5]); w0.w = cvtpk(v[6], v[7]);
          w1.x = cvtpk(v[8], v[9]); w1.y = cvtpk(v[10], v[11]); w1.z = cvtpk(v[12], v[13]); w1.w = cvtpk(v[14], v[15]);
          *(u32x4*)dst = w0; *(u32x4*)(dst + 8) = w1;
          red[(d * 8 + pg) * 64 + dk] = pn; } }
    __syncthreads();
    if (tid < 128) { const int d = tid >> 6, dk = tid & 63; float a = 0.f;
#pragma unroll
        for (int q = 0; q < 8; ++q) a += red[(d * 8 + q) * 64 + dk];
        WSP(float, WS_UN)[((size_t)((b * 4 + h) * 2 + d) * NCHUNK + scan_index(cp, d)) * 64 + dk] = a; }
    { const int tm = wid >> 1, tn = wid & 1, r32 = lane & 31, hi2 = lane >> 5;
#pragma unroll
      for (int d = 0; d < 2; ++d) { f32x16 acc = {};
#pragma unroll
          for (int ks = 0; ks < 8; ++ks) { const bf16x8 A = *(const bf16x8*)(vt + (32 * tm + r32) * 136 + 16 * ks + 8 * hi2);
              const bf16x8 B = *(const bf16x8*)(ktw + d * (64 * 136) + (32 * tn + r32) * 136 + 16 * ks + 8 * hi2);
              acc = __builtin_amdgcn_mfma_f32_32x32x16_bf16(A, B, acc, 0, 0, 0); }
          float* U = WSP(float, WS_U) + ((size_t)((b * 4 + h) * 2 + d) * NCHUNK + scan_index(cp, d)) * 8192;
#pragma unroll
          for (int r = 0; r < 16; ++r) U[(32 * tm + att::crow(r, hi2)) * 64 + 32 * tn + r32] = acc[r]; } }
    __syncthreads();
}

__device__ __forceinline__ void mlstm_scan(const Ctx& C) {
    PHASE_IDS();
    const float* ST = WSP(float, WS_USTAT);
    for (int e = C.blk * NTHREADS + tid; e < 16 * 8192; e += C.G * NTHREADS) {
        const bool two = e < 16 * 64;
        const int chain0 = e >> 13, el0 = e & 8191, chain1 = two ? (e >> 6) : chain0, el1 = e & 63;
        const float* src0 = WSP(float, WS_U) + (size_t)chain0 * NCHUNK * 8192 + el0;
        const float* src1 = WSP(float, WS_UN) + (size_t)chain1 * NCHUNK * 64 + el1;
        float c0 = 0.f, m0 = 0.f, c1 = 0.f, m1 = 0.f;
#pragma unroll 1
        for (int s0 = 0; s0 < NCHUNK; s0 += 11) {
            float u0[11], um0[11], bl0[11], u1[11], um1[11], bl1[11];
#pragma unroll
            for (int q = 0; q < 11; ++q) { u0[q] = src0[(size_t)(s0 + q) * 8192]; um0[q] = ST[(chain0 * NCHUNK + s0 + q) * 2]; bl0[q] = ST[(chain0 * NCHUNK + s0 + q) * 2 + 1];
                if (two) { u1[q] = src1[(size_t)(s0 + q) * 64]; um1[q] = ST[(chain1 * NCHUNK + s0 + q) * 2]; bl1[q] = ST[(chain1 * NCHUNK + s0 + q) * 2 + 1]; } else { u1[q] = 0.f; um1[q] = 0.f; bl1[q] = 0.f; } }
#pragma unroll
            for (int q = 0; q < 11; ++q) { const int s = s0 + q;
                WSP(bf16, WS_CST)[((size_t)chain0 * NCHUNK + s) * 8192 + el0] = f2bf(c0); if (el0 == 0) WSP(float, WS_MST)[chain0 * NCHUNK + s] = m0;
                { const float mx = fmaxf(m0, um0[q]); c0 = __expf(m0 - mx) * c0 + __expf(um0[q] - mx) * u0[q]; m0 = bl0[q] + mx; }
                if (two) { WSP(float, WS_NST)[((size_t)chain1 * NCHUNK + s) * 64 + el1] = c1;
                    const float mx = fmaxf(m1, um1[q]); c1 = __expf(m1 - mx) * c1 + __expf(um1[q] - mx) * u1[q]; m1 = bl1[q] + mx; } }
        }
    }
}

__device__ __forceinline__ void mlstm_scan_window(const Ctx& C, int b0, int nb) {
    PHASE_IDS();
    if (C.blk < b0 || C.blk >= b0 + nb) return;
    const float* ST = WSP(float, WS_USTAT);
    const int gt = (C.blk - b0) * NTHREADS + tid, nthr = nb * NTHREADS;
    for (int e8 = gt; e8 < (16 * 8192 + 16 * 64) / 8; e8 += nthr) {
        const bool isn = e8 >= 16 * 8192 / 8;
        const int ee = (isn ? e8 - 16 * 8192 / 8 : e8) * 8, chain = isn ? (ee >> 6) : (ee >> 13), el = isn ? (ee & 63) : (ee & 8191), stride = isn ? 64 : 8192;
        const float* src = (isn ? WSP(float, WS_UN) : WSP(float, WS_U)) + (size_t)chain * NCHUNK * stride + el;
        f32x4 c0 = {0.f, 0.f, 0.f, 0.f}, c1 = c0; float m = 0.f;
#pragma unroll 1
        for (int s0 = 0; s0 < NCHUNK; s0 += 11) {
            f32x4 u0[11], u1[11]; float um[11], bl[11];
#pragma unroll
            for (int q = 0; q < 11; ++q) { u0[q] = *(const f32x4*)(src + (size_t)(s0 + q) * stride); u1[q] = *(const f32x4*)(src + (size_t)(s0 + q) * stride + 4);
                um[q] = ST[(chain * NCHUNK + s0 + q) * 2]; bl[q] = ST[(chain * NCHUNK + s0 + q) * 2 + 1]; }
#pragma unroll
            for (int q = 0; q < 11; ++q) { const int s = s0 + q;
                if (isn) { float* d = WSP(float, WS_NST) + ((size_t)chain * NCHUNK + s) * 64 + el; *(f32x4*)d = c0; *(f32x4*)(d + 4) = c1; }
                else { u32x4 w; w.x = cvtpk(c0[0], c0[1]); w.y = cvtpk(c0[2], c0[3]); w.z = cvtpk(c1[0], c1[1]); w.w = cvtpk(c1[2], c1[3]);
                    *(u32x4*)(WSP(bf16, WS_CST) + ((size_t)chain * NCHUNK + s) * 8192 + el) = w; if (el == 0) WSP(float, WS_MST)[chain * NCHUNK + s] = m; }
                const float mx = fmaxf(m, um[q]); const float a = __expf(m - mx), bb = __expf(um[q] - mx);
                c0 = c0 * a + u0[q] * bb; c1 = c1 * a + u1[q] * bb; m = bl[q] + mx; }
        }
    }
}

__device__ __forceinline__ void mlstm_c_unit(const Ctx& C, int l, int unit, char* lds) {
    const int b = unit / (4 * NCHUNK), h = (unit / NCHUNK) & 3, cp = unit % NCHUNK;
    int row0, lo, hi; chunk_geom(b, cp, row0, lo, hi);
    bf16* Qs = (bf16*)lds;
    bf16* Ks = (bf16*)(lds + 18432);
    bf16* vt = (bf16*)(lds + 36864);
    bf16* Pw = (bf16*)(lds + 36864 + 34816);
    float* gi = (float*)(lds + 36864 + 2 * 34816);
    float* glf = gi + 256; float* bc = glf + 256; float* uu = bc + 256; float* rr = uu + 256; float* npv = rr + 256;
    float* wsc = npv + 128;
    const int tid = opaque_tid(), lane = tid & 63, wid = __builtin_amdgcn_readfirstlane(tid >> 6);
    float* cwl = (float*)(lds + ML_CW_OFF);
    { MlHead H; ml_head_load<true>(C, l, row0, lo, hi, h, tid, H);
      const float npvv = WSP(float, WS_NST)[((size_t)((b * 4 + h) * 2 + ((tid >> 6) & 1)) * NCHUNK + scan_index(cp, (tid >> 6) & 1)) * 64 + (tid & 63)];
      ml_head_stage(H, h, tid, gi, glf, cwl);
      const int pos = tid >> 2, part = tid & 3;
      ml_vscatter(H, vt, pos, part);
      if (tid < 128) npv[tid] = npvv;
      __syncthreads();
      float o[16];
      ml_conv16(H.qa0, H.qa1, H.qp0, H.qp1, H.qq0, H.qq1, H.okp, H.okq, cwl, 0, part, 1.f, o);
      { u32x4 w0, w1; w0.x = cvtpk(o[0], o[1]); w0.y = cvtpk(o[2], o[3]); w0.z = cvtpk(o[4], o[5]); w0.w = cvtpk(o[6], o[7]);
        w1.x = cvtpk(o[8], o[9]); w1.y = cvtpk(o[10], o[11]); w1.z = cvtpk(o[12], o[13]); w1.w = cvtpk(o[14], o[15]);
        *(u32x4*)(Qs + pos * 72 + part * 16) = w0; *(u32x4*)(Qs + pos * 72 + part * 16 + 8) = w1; }
      ml_conv16(H.ka0, H.ka1, H.kp0, H.kp1, H.kq0, H.kq1, H.okp, H.okq, cwl, 1, part, 0.125f, o);
      { u32x4 w0, w1; w0.x = cvtpk(o[0], o[1]); w0.y = cvtpk(o[2], o[3]); w0.z = cvtpk(o[4], o[5]); w0.w = cvtpk(o[6], o[7]);
        w1.x = cvtpk(o[8], o[9]); w1.y = cvtpk(o[10], o[11]); w1.z = cvtpk(o[12], o[13]); w1.w = cvtpk(o[14], o[15]);
        *(u32x4*)(Ks + pos * 72 + part * 16) = w0; *(u32x4*)(Ks + pos * 72 + part * 16 + 8) = w1; } }
    __syncthreads();
    float mprev[2];
#pragma unroll
    for (int d = 0; d < 2; ++d) mprev[d] = WSP(float, WS_MST)[((b * 4 + h) * 2 + d) * NCHUNK + scan_index(cp, d)];
    if (wid < 2) { float umax, blast; gate_scan<true>(wid, lane, gi, glf, bc, uu, rr, wid == 0 ? mprev[0] : mprev[1], umax, blast); }
    __syncthreads();
    const int il = lane & 15, g4 = lane >> 4, ig = 16 * wid + il;
    unsigned short ogv[8][4];
#pragma unroll
    for (int nb = 0; nb < 8; ++nb)
#pragma unroll
        for (int r = 0; r < 4; ++r) ogv[nb][r] = WSP(bf16, WS_Z)[(size_t)(row0 + 16 * wid + 4 * g4 + r) * ZW + ZOG + h * 128 + 16 * nb + il];
    bf16x8 qf[2];
#pragma unroll
    for (int ks = 0; ks < 2; ++ks) qf[ks] = *(const bf16x8*)(Qs + ig * 72 + 32 * ks + 8 * g4);
    bf16* Pme = Pw + wid * (16 * 136); float* sc = wsc + wid * 16;
    f32x4 hacc[8];
#pragma unroll
    for (int nb = 0; nb < 8; ++nb) hacc[nb] = (f32x4){0.f, 0.f, 0.f, 0.f};
#pragma unroll
    for (int d = 0; d < 2; ++d) {
        const float r_i = rr[d * 128 + ig], b_i = bc[d * 128 + ig];
        const float wprev = __expf(mprev[d] - r_i);
        float qn = 0.f;
#pragma unroll
        for (int ks = 0; ks < 2; ++ks)
#pragma unroll
            for (int e = 0; e < 8; ++e) qn += bf2f((unsigned short)qf[ks][e]) * npv[d * 64 + 32 * ks + 8 * g4 + e];
        qn += __shfl_xor(qn, 16); qn += __shfl_xor(qn, 32);
        f32x4 acc[8];
        const bf16* Cp = WSP(bf16, WS_CST) + ((size_t)((b * 4 + h) * 2 + d) * NCHUNK + scan_index(cp, d)) * 8192;
        bf16x8 cf[8][2];
#pragma unroll
        for (int nb = 0; nb < 8; ++nb)
#pragma unroll
            for (int ks = 0; ks < 2; ++ks) cf[nb][ks] = *(const bf16x8*)(Cp + (16 * nb + il) * 64 + 32 * ks + 8 * g4);
        if (lane < 16) sc[16 * 8 + il] = wprev;
        float rsum = 0.f;
#pragma unroll
        for (int jb = 0; jb < 8; ++jb) { f32x4 s = {0.f, 0.f, 0.f, 0.f};
#pragma unroll
            for (int ks = 0; ks < 2; ++ks) { const bf16x8 kf = *(const bf16x8*)(Ks + (16 * jb + il) * 72 + 32 * ks + 8 * g4);
                s = __builtin_amdgcn_mfma_f32_16x16x32_bf16(kf, qf[ks], s, 0, 0, 0); }
            const f32x4 u4 = *(const f32x4*)(uu + d * 128 + 16 * jb + 4 * g4);
            float p[4];
#pragma unroll
            for (int r = 0; r < 4; ++r) { const int j = 16 * jb + 4 * g4 + r; const bool ok = d ? (j >= ig) : (j <= ig);
                p[r] = ok ? s[r] * __expf(u4[r] - r_i) : 0.f; rsum += p[r]; }
            u32x2 w; w.x = cvtpk(p[0], p[1]); w.y = cvtpk(p[2], p[3]);
            *(u32x2*)(Pme + il * 136 + 16 * jb + 4 * g4) = w; }
        rsum += __shfl_xor(rsum, 16); rsum += __shfl_xor(rsum, 32);
        const float den = rsum + wprev * qn;
        const float dn = fmaxf(fabsf(den), __expf(-b_i - r_i));
        LDS_WAIT();
        if (lane < 16) sc[il] = 1.f / dn;
        LDS_WAIT();
#pragma unroll
        for (int nb = 0; nb < 8; ++nb) { acc[nb] = (f32x4){0.f, 0.f, 0.f, 0.f};
#pragma unroll
            for (int ks = 0; ks < 2; ++ks) acc[nb] = __builtin_amdgcn_mfma_f32_16x16x32_bf16(qf[ks], cf[nb][ks], acc[nb], 0, 0, 0); }
        { const f32x4 wp4 = *(const f32x4*)(sc + 16 * 8 + 4 * g4);
#pragma unroll
          for (int nb = 0; nb < 8; ++nb) acc[nb] *= wp4; }
#pragma unroll
        for (int ks = 0; ks < 4; ++ks) { const bf16x8 pf = *(const bf16x8*)(Pme + il * 136 + 32 * ks + 8 * g4);
#pragma unroll
            for (int nb = 0; nb < 8; ++nb) { const bf16x8 vf = *(const bf16x8*)(vt + (16 * nb + il) * 136 + 32 * ks + 8 * g4);
                acc[nb] = __builtin_amdgcn_mfma_f32_16x16x32_bf16(pf, vf, acc[nb], 0, 0, 0); } }
        { const f32x4 inv4 = *(const f32x4*)(sc + 4 * g4);
#pragma unroll
          for (int nb = 0; nb < 8; ++nb) hacc[nb] += acc[nb] * inv4; }
        LDS_WAIT();
    }
    f32x4 sum = {0.f, 0.f, 0.f, 0.f};
#pragma unroll
    for (int nb = 0; nb < 8; ++nb) sum += hacc[nb];
#pragma unroll
    for (int r = 0; r < 4; ++r) { float s = sum[r]; s += __shfl_xor(s, 1); s += __shfl_xor(s, 2); s += __shfl_xor(s, 4); s += __shfl_xor(s, 8); sum[r] = s * (1.f / 128.f); }
    f32x4 sq = {0.f, 0.f, 0.f, 0.f};
#pragma unroll
    for (int nb = 0; nb < 8; ++nb) { const f32x4 dd = hacc[nb] - sum; sq += dd * dd; }
#pragma unroll
    for (int r = 0; r < 4; ++r) { float s = sq[r]; s += __shfl_xor(s, 1); s += __shfl_xor(s, 2); s += __shfl_xor(s, 4); s += __shfl_xor(s, 8); sq[r] = rsqrtf(s * (1.f / 128.f) + LN_EPS); }
    const float* ng = CIN(IN_ANORM) + l * 512 + h * 128;
    float gnv[8];
#pragma unroll
    for (int nb = 0; nb < 8; ++nb) gnv[nb] = ng[16 * nb + il];
#pragma unroll
    for (int nb = 0; nb < 8; ++nb) { const int dv = 16 * nb + il; const float gn = gnv[nb];
#pragma unroll
        for (int r = 0; r < 4; ++r) { const size_t row = (size_t)(row0 + 16 * wid + 4 * g4 + r);
            const float og = bf2f(ogv[nb][r]);
            WSP(bf16, WS_MIX)[row * D + h * 128 + dv] = f2bf((hacc[nb][r] - sum[r]) * sq[r] * gn * sigmoidf_(og)); } }
    __syncthreads();
}

__device__ __forceinline__ void phase_ln1(const Ctx& C, int l, char* lds) {
    PHASE_IDS();
    const int rows_total = (l == 0) ? M : NL;
    const int rpb = (rows_total + C.G - 1) / C.G, r_lo = C.blk * rpb, r_hi = (r_lo + rpb < rows_total) ? r_lo + rpb : rows_total;
    constexpr int TROW = 2056;
    bf16* TH = (bf16*)lds;
    bf16* TL = TH + 8 * TROW;
    float* RED = (float*)(lds + 2 * 8 * TROW * 2);
    int* lcnt = (int*)(RED + 8 * 8 * 32);
    int* gbase = lcnt + 16;
    int* rinfo = gbase + 16;
    float* rwt = (float*)(rinfo + 4 * 72);
    float* PV = rwt + 2 * 72;
    const int s_lo = mod_set(r_lo), s_hi = mod_set(r_hi > r_lo ? r_hi - 1 : r_lo);
    { const float* lg_ = CIN(IN_LN1G) + l * D; const float* lb_ = CIN(IN_LN1B) + l * D; const float* md_all_ = WSP(float, WS_MOD) + (size_t)l * 3 * 12288;
      for (int i = tid; i < 8 * (D / 4); i += NTHREADS) { const int v = i / (D / 4), k = (i % (D / 4)) * 4; f32x4 x;
          if (v == 0) x = *(const f32x4*)(lg_ + k); else if (v == 1) x = *(const f32x4*)(lb_ + k);
          else { const int sset = ((v - 2) / 3 == 0) ? s_lo : s_hi, q = (v - 2) % 3; x = *(const f32x4*)(md_all_ + (size_t)sset * 12288 + (2 + q) * 2048 + k); }
          *(f32x4*)(PV + v * D + k) = x; } }
    if (tid < 16) lcnt[tid] = 0;
    __syncthreads();
    const float* px = CIN(IN_X); const float* pcx = CIN(IN_CTX); const float* brg = CIN(IN_BRG) + l * 4; const float* bre = CIN(IN_BRE) + l * 16;
    const bf16* wrh = WSP(bf16, WS_WRT) + (size_t)(l * 2 + 0) * 32 * D; const bf16* wrl = WSP(bf16, WS_WRT) + (size_t)(l * 2 + 1) * 32 * D;
    f32x4 cx[8]; u32x2 cy[8];
#define LN1_LOAD(nn, X, Y) do { const float* xr_ = (l == 0) ? x0_row(px, pcx, (nn)) : (WSP(float, WS_XRES) + (size_t)(nn) * D); const bf16* yr_ = WSP(bf16, WS_Y) + (size_t)(nn) * D; \
        _Pragma("unroll") for (int j = 0; j < 8; ++j) { const int k = 4 * lane + 256 * j; X[j] = *(const f32x4*)(xr_ + k); Y[j] = *(const u32x2*)(yr_ + k); } } while (0)
    if (r_lo + wave < r_hi) LN1_LOAD(r_lo + wave, cx, cy);
    for (int n0 = r_lo; n0 < r_hi; n0 += NWAVES) {
        const int n = n0 + wave; const bool valid = n < r_hi;
        f32x4 nx[8]; u32x2 ny[8];
#pragma unroll
        for (int j = 0; j < 8; ++j) { nx[j] = cx[j]; ny[j] = cy[j]; }
        if (n + NWAVES < r_hi) LN1_LOAD(n + NWAVES, nx, ny);
        f32x4 sx[8]; u32x2 st_[8];
        if (valid) {
            const float* pm = PV + (2 + ((mod_set(n) == s_lo) ? 0 : 3)) * D;
            f32x4 v[8]; float s = 0.f;
#pragma unroll
            for (int j = 0; j < 8; ++j) { const int k = 4 * lane + 256 * j;
                const f32x4 x = cx[j]; const u32x2 yw = cy[j]; const f32x4 g2 = *(const f32x4*)(pm + k);
                const f32x4 y = {bflo(yw.x), bfhi(yw.x), bflo(yw.y), bfhi(yw.y)};
                v[j] = x * ALPHA + g2 * y; s += (v[j][0] + v[j][1]) + (v[j][2] + v[j][3]); }
            const float mean = wave_sum(s) * (1.f / D); float s2 = 0.f;
#pragma unroll
            for (int j = 0; j < 8; ++j) { v[j] = v[j] - mean; s2 += (v[j][0] * v[j][0] + v[j][1] * v[j][1]) + (v[j][2] * v[j][2] + v[j][3] * v[j][3]); }
            const float rstd = rsqrtf(wave_sum(s2) * (1.f / D) + LN_EPS);
#pragma unroll
            for (int j = 0; j < 8; ++j) { const int k = 4 * lane + 256 * j;
                const f32x4 x1 = v[j] * rstd * *(const f32x4*)(PV + k) + *(const f32x4*)(PV + D + k);
                sx[j] = x1;
                const f32x4 tt = x1 * (*(const f32x4*)(pm + 2 * D + k) + 1.f) + *(const f32x4*)(pm + D + k);
                u32x2 wh; wh.x = cvtpk(tt[0], tt[1]); wh.y = cvtpk(tt[2], tt[3]);
                st_[j] = wh;
                u32x2 wl; wl.x = cvtpk(tt[0] - bflo(wh.x), tt[1] - bfhi(wh.x)); wl.y = cvtpk(tt[2] - bflo(wh.y), tt[3] - bfhi(wh.y));
                *(u32x2*)(TH + wave * TROW + k) = wh; *(u32x2*)(TL + wave * TROW + k) = wl; }
        } else {
#pragma unroll
            for (int j = 0; j < 8; ++j) { const int k = 4 * lane + 256 * j; *(u32x2*)(TH + wave * TROW + k) = (u32x2){0u, 0u}; *(u32x2*)(TL + wave * TROW + k) = (u32x2){0u, 0u}; }
        }
        { const int il = lane & 15, g4 = lane >> 4, r8 = il & 7;
          bf16x8 wq[4][4];
#define LN1_WLOAD(ks0_) do { _Pragma("unroll") for (int ks = 0; ks < 4; ++ks) { const int k = 256 * wave + 32 * ((ks0_) + ks) + 8 * g4; \
              wq[ks][0] = *(const bf16x8*)(wrh + (size_t)il * D + k); wq[ks][1] = *(const bf16x8*)(wrl + (size_t)il * D + k); \
              wq[ks][2] = *(const bf16x8*)(wrh + (size_t)(16 + il) * D + k); wq[ks][3] = *(const bf16x8*)(wrl + (size_t)(16 + il) * D + k); } } while (0)
#define LN1_WMMA(ks0_) do { _Pragma("unroll") for (int ks = 0; ks < 4; ++ks) { const int k = 256 * wave + 32 * ((ks0_) + ks) + 8 * g4; \
              const bf16x8 ah = *(const bf16x8*)(TH + r8 * TROW + k), al = *(const bf16x8*)(TL + r8 * TROW + k); \
              acc0 = __builtin_amdgcn_mfma_f32_16x16x32_bf16(ah, wq[ks][0], acc0, 0, 0, 0); acc0 = __builtin_amdgcn_mfma_f32_16x16x32_bf16(al, wq[ks][0], acc0, 0, 0, 0); acc0 = __builtin_amdgcn_mfma_f32_16x16x32_bf16(ah, wq[ks][1], acc0, 0, 0, 0); \
              acc1 = __builtin_amdgcn_mfma_f32_16x16x32_bf16(ah, wq[ks][2], acc1, 0, 0, 0); acc1 = __builtin_amdgcn_mfma_f32_16x16x32_bf16(al, wq[ks][2], acc1, 0, 0, 0); acc1 = __builtin_amdgcn_mfma_f32_16x16x32_bf16(ah, wq[ks][3], acc1, 0, 0, 0); } } while (0)
          LN1_WLOAD(0); SBAR();
          LDS_BARRIER();
          f32x4 acc0 = {0.f, 0.f, 0.f, 0.f}, acc1 = acc0;
          LN1_WMMA(0); SBAR();
          LN1_WLOAD(4); SBAR();
          LN1_WMMA(4); SBAR();
#undef LN1_WLOAD
#undef LN1_WMMA
          if (g4 < 2) {
#pragma unroll
              for (int r = 0; r < 4; ++r) { RED[(wave * 8 + 4 * g4 + r) * 32 + il] = acc0[r]; RED[(wave * 8 + 4 * g4 + r) * 32 + 16 + il] = acc1[r]; } } }
        if (valid) {
#pragma unroll
            for (int j = 0; j < 8; ++j) { const int k = 4 * lane + 256 * j;
                __builtin_nontemporal_store(sx[j], (f32x4*)(WSP(float, WS_XRES) + (size_t)n * D + k));
                __builtin_nontemporal_store(st_[j], (u32x2*)(WSP(bf16, WS_HB) + (size_t)n * D + k)); } }
        LDS_BARRIER();
        { float lv = 0.f;
          if (lane < 32) {
#pragma unroll
              for (int q = 0; q < 8; ++q) lv += RED[(q * 8 + wave) * 32 + lane]; }
          float lgt[20];
#pragma unroll
          for (int q = 0; q < 20; ++q) lgt[q] = __shfl(lv, q);
          if (valid) {
            float gl[4]; int gidx = 0; float gmax;
#pragma unroll
            for (int q = 0; q < 4; ++q) gl[q] = lgt[q] + brg[q];
            gmax = gl[0];
#pragma unroll
            for (int q = 1; q < 4; ++q) if (gl[q] > gmax) { gmax = gl[q]; gidx = q; }
            float gs = 0.f;
#pragma unroll
            for (int q = 0; q < 4; ++q) gs += __expf(gl[q] - gmax);
            const float gw = 1.f / gs;
            float ein[4] = {0.f, 0.f, 0.f, 0.f};
#pragma unroll
            for (int gq = 0; gq < 4; ++gq)
#pragma unroll
                for (int q = 0; q < 4; ++q) ein[q] = (gidx == gq) ? (lgt[4 + 4 * gq + q] + bre[4 * gq + q]) : ein[q];
            int i0 = 0; float m0 = ein[0];
#pragma unroll
            for (int q = 1; q < 4; ++q) if (ein[q] > m0) { m0 = ein[q]; i0 = q; }
            int i1 = -1; float m1 = -3.0e38f;
#pragma unroll
            for (int q = 0; q < 4; ++q) if (q != i0 && ein[q] > m1) { m1 = ein[q]; i1 = q; }
            const float p1 = __expf(m1 - m0);
            const float w0 = gw / (1.f + p1), w1 = gw * p1 / (1.f + p1);
            if (lane == 0) { const int e0 = gidx * 4 + i0, e1 = gidx * 4 + i1, r = n - r_lo;
                const int k0 = atomicAdd(&lcnt[e0], 1), k1 = atomicAdd(&lcnt[e1], 1);
                rinfo[4 * r] = e0; rinfo[4 * r + 1] = k0; rinfo[4 * r + 2] = e1; rinfo[4 * r + 3] = k1; rwt[2 * r] = w0; rwt[2 * r + 1] = w1; }
          } }
#pragma unroll
        for (int j = 0; j < 8; ++j) { cx[j] = nx[j]; cy[j] = ny[j]; }
    }
#undef LN1_LOAD
    __syncthreads();
    if (tid < 16) gbase[tid] = (int)__hip_atomic_fetch_add((unsigned*)(C.ws + WS_CTL) + CW_CNT + l * 16 + tid, (unsigned)lcnt[tid], __ATOMIC_RELAXED, __HIP_MEMORY_SCOPE_AGENT);
    __syncthreads();
    for (int r = tid; r < r_hi - r_lo; r += NTHREADS) { const int n = r_lo + r;
#pragma unroll
        for (int q = 0; q < 2; ++q) { const int e = rinfo[4 * r + 2 * q], pos = gbase[e] + rinfo[4 * r + 2 * q + 1];
            WSP(int, WS_LIST)[(size_t)e * M + pos] = n; WSP(float, WS_ROWW)[(size_t)e * M + pos] = rwt[2 * r + q];
            WSP(int, WS_TSLOT)[2 * n + q] = (e << 20) | pos; } }
    __syncthreads();
}
__device__ __forceinline__ void moe_tables(const Ctx& C, int l, char* lds) {
    int* tpg = (int*)(lds + LDS_MISC + 64); int* cng = (int*)(lds + LDS_MISC + 136);
    const int t = opaque_tid();
    if (t < 16) cng[t] = (int)__hip_atomic_load((unsigned*)(C.ws + WS_CTL) + CW_CNT + l * 16 + t, __ATOMIC_RELAXED, __HIP_MEMORY_SCOPE_AGENT);
    __syncthreads();
    if (t == 0) { int a = 0; tpg[0] = 0; for (int e = 0; e < 16; ++e) { a += (cng[e] + 255) >> 8; tpg[e + 1] = a; } }
    __syncthreads();
}
struct Ln2Raw { f32x4 x[8]; u32x2 fa[8], fb[8]; };
__device__ __forceinline__ void ln2_load(const Ctx& C, const int* tpg, int n, int lane, Ln2Raw& R) {
    const int ts0 = WSP(int, WS_TSLOT)[2 * n], ts1 = WSP(int, WS_TSLOT)[2 * n + 1];
    const size_t s0 = (size_t)tpg[ts0 >> 20] * 256 + (ts0 & 0xFFFFF), s1 = (size_t)tpg[ts1 >> 20] * 256 + (ts1 & 0xFFFFF);
    const bf16* f0 = WSP(bf16, WS_FSLOT) + s0 * D; const bf16* f1 = WSP(bf16, WS_FSLOT) + s1 * D;
    const float* xr = WSP(float, WS_XRES) + (size_t)n * D;
#pragma unroll
    for (int j = 0; j < 8; ++j) { const int k = 4 * lane + 256 * j; R.x[j] = *(const f32x4*)(xr + k); R.fa[j] = *(const u32x2*)(f0 + k); R.fb[j] = *(const u32x2*)(f1 + k); }
}
__device__ __forceinline__ void phase_ln2(const Ctx& C, int l, char* lds) {
    const int rows_total = (l == 0) ? M : NL;
    const int* tpg = (const int*)(lds + LDS_MISC + 64);
    float* PV = (float*)lds;
    { const int t = opaque_tid(); const float* lg = CIN(IN_LN2G) + l * D; const float* lb = CIN(IN_LN2B) + l * D;
      const float* md_all = WSP(float, WS_MOD) + (size_t)l * 3 * 12288; const float* mdn_all = WSP(float, WS_MOD) + (size_t)(l + 1) * 3 * 12288;
      for (int i = t; i < 11 * (D / 4); i += NTHREADS) { const int v = i / (D / 4), k = (i % (D / 4)) * 4; f32x4 x;
          if (v == 0) x = *(const f32x4*)(lg + k); else if (v == 1) x = *(const f32x4*)(lb + k);
          else { const int sset = (v - 2) / 3, q = (v - 2) % 3;
              if (q == 0) x = *(const f32x4*)(md_all + (size_t)sset * 12288 + 5 * 2048 + k);
              else if (l + 1 < DEPTH) x = *(const f32x4*)(mdn_all + (size_t)sset * 12288 + (q == 1 ? 2048 : 0) + k);
              else x = (f32x4){0.f, 0.f, 0.f, 0.f}; }
          *(f32x4*)(PV + v * D + k) = x; } }
    __syncthreads();
    const int lane = opaque_tid() & 63;
    const int gw = C.blk * NWAVES + __builtin_amdgcn_readfirstlane(opaque_tid() >> 6), NGW = C.G * NWAVES;
    int n = gw;
    Ln2Raw cur; if (n < rows_total) ln2_load(C, tpg, n, lane, cur);
    for (; n < rows_total; n += NGW) {
        Ln2Raw nxt = cur; if (n + NGW < rows_total) ln2_load(C, tpg, n + NGW, lane, nxt);
        const float* pm = PV + (2 + 3 * mod_set(n)) * D;
        f32x4 v[8]; float s = 0.f;
#pragma unroll
        for (int j = 0; j < 8; ++j) { const int k = 4 * lane + 256 * j;
            const u32x2 a = cur.fa[j], bq = cur.fb[j]; const f32x4 g5 = *(const f32x4*)(pm + k);
            const f32x4 f = {bflo(a.x) + bflo(bq.x), bfhi(a.x) + bfhi(bq.x), bflo(a.y) + bflo(bq.y), bfhi(a.y) + bfhi(bq.y)};
            v[j] = cur.x[j] * ALPHA + g5 * f; s += (v[j][0] + v[j][1]) + (v[j][2] + v[j][3]); }
        const float mean = wave_sum(s) * (1.f / D); float s2 = 0.f;
#pragma unroll
        for (int j = 0; j < 8; ++j) { v[j] = v[j] - mean; s2 += (v[j][0] * v[j][0] + v[j][1] * v[j][1]) + (v[j][2] * v[j][2] + v[j][3] * v[j][3]); }
        const float rstd = rsqrtf(wave_sum(s2) * (1.f / D) + LN_EPS);
#pragma unroll
        for (int j = 0; j < 8; ++j) { const int k = 4 * lane + 256 * j;
            const f32x4 x2 = v[j] * rstd * *(const f32x4*)(PV + k) + *(const f32x4*)(PV + D + k);
            if (l == DEPTH - 1) __builtin_nontemporal_store(x2, (f32x4*)(C.out + (size_t)n * D + k));
            else { __builtin_nontemporal_store(x2, (f32x4*)(WSP(float, WS_XRES) + (size_t)n * D + k));
                const f32x4 hh = x2 * (*(const f32x4*)(pm + D + k) + 1.f) + *(const f32x4*)(pm + 2 * D + k);
                u32x2 w; w.x = cvtpk(hh[0], hh[1]); w.y = cvtpk(hh[2], hh[3]);
                __builtin_nontemporal_store(w, (u32x2*)(WSP(bf16, WS_HB) + (size_t)n * D + k)); } }
        cur = nxt;
    }
    __syncthreads();
}

#ifdef PROBE_ATTCHK
__device__ __forceinline__ void att_check(const Ctx& C, char* lds, int mla) {
    PHASE_IDS();
    float* sc = (float*)lds;
    float* red = sc + 8448;
    float* qv = red + 512;
    const int nh = mla ? 4 : 8, dq = mla ? 192 : 128;
    const int h = C.blk % nh, n = (C.blk * 67 + 13) % NL, b = n >> 13;
    const bf16* q = mla ? (WSP(bf16, WS_QM) + (size_t)n * 768 + h * 192) : (WSP(bf16, WS_QG) + (size_t)n * 1024 + h * 128);
    const bf16* K = mla ? (WSP(bf16, WS_KM) + (size_t)(b * 4 + h) * SKV * 192) : (WSP(bf16, WS_KG) + (size_t)(b * 2 + (h >> 2)) * SKV * 128);
    const bf16* V = mla ? (WSP(bf16, WS_VM) + (size_t)(b * 4 + h) * SKV * 128) : (WSP(bf16, WS_VG) + (size_t)(b * 2 + (h >> 2)) * SKV * 128);
    if (tid < dq) qv[tid] = bf2f(q[tid]);
    __syncthreads();
    const float scale = 0.6931471805599453f;
    float mx = -3e38f;
    for (int j = tid; j < SKV; j += NTHREADS) { float a = 0.f; for (int d = 0; d < dq; ++d) a += qv[d] * bf2f(K[(size_t)j * dq + d]); a *= scale; sc[j] = a; mx = fmaxf(mx, a); }
    red[tid] = mx; __syncthreads();
    for (int o = 256; o > 0; o >>= 1) { if (tid < o) red[tid] = fmaxf(red[tid], red[tid + o]); __syncthreads(); }
    mx = red[0]; __syncthreads();
    float sm = 0.f;
    for (int j = tid; j < SKV; j += NTHREADS) { const float p = __expf(sc[j] - mx); sc[j] = p; sm += p; }
    red[tid] = sm; __syncthreads();
    for (int o = 256; o > 0; o >>= 1) { if (tid < o) red[tid] += red[tid + o]; __syncthreads(); }
    sm = red[0]; __syncthreads();
    const int d = tid & 127, part = tid >> 7; float a = 0.f;
    for (int j = part; j < SKV; j += 4) a += sc[j] * bf2f(V[(size_t)j * 128 + d]);
    red[tid] = a; __syncthreads();
    float ref = 0.f, got = 0.f;
    if (tid < 128) { ref = (red[tid] + red[tid + 128] + red[tid + 256] + red[tid + 384]) / sm;
        got = bf2f(WSP(bf16, WS_MIX)[(size_t)n * D + (mla ? 1536 : 512) + h * 128 + tid]); }
    __syncthreads();
    red[tid] = (tid < 128) ? fabsf(ref) : 0.f; __syncthreads();
    for (int o = 256; o > 0; o >>= 1) { if (tid < o) red[tid] = fmaxf(red[tid], red[tid + o]); __syncthreads(); }
    const float rmax = red[0]; __syncthreads();
    red[tid] = (tid < 128) ? fabsf(ref - got) : 0.f; __syncthreads();
    for (int o = 256; o > 0; o >>= 1) { if (tid < o) red[tid] = fmaxf(red[tid], red[tid + o]); __syncthreads(); }
    if (tid == 0) { const float e = red[0] / fmaxf(rmax, 1e-20f); atomicMax((unsigned*)(C.ws + WS_CTL) + CW_CHK, __float_as_uint(e)); }
    __syncthreads();
}
#endif

#ifdef PROBE_PREPCHK
__device__ __forceinline__ float prep_rope_ang(int i, int nf, int prow, int pcol) { const int f = i < nf ? i : i - nf; const float inv = powf(10000.f, -(float)f / (float)nf); return (float)(i < nf ? prow : pcol) * inv; }
__device__ __forceinline__ void prep_check(const Ctx& C, char* lds, int l) {
    PHASE_IDS();
    float* hv = (float*)lds;
    float* zv = hv + 2048;
    float* tv = zv + 1024;
    float* red = tv + 1024;
    const int kind = C.blk & 3, sel = C.blk >> 2;
    const int n = (C.blk & 4) ? (NL + (C.blk * 37) % NC) : ((C.blk * 67 + 13) % NL);
    const bool lat = n < NL; int b, pos, prow = 0, pcol = 0;
    if (lat) { b = n >> 13; const int t = n & (T - 1); pos = CTXL + t; prow = t >> 6; pcol = t & 63; } else { b = (n - NL) >> 8; pos = (n - NL) & 255; }
    for (int k = tid; k < D; k += NTHREADS) hv[k] = bf2f(WSP(bf16, WS_HB)[(size_t)n * D + k]);
    __syncthreads();
    const float* win = CIN(IN_WIN) + (size_t)l * D * INW;
    const int hq = sel & 7, kvh = sel & 1, hm = sel & 3;
    const int ncol = kind == 0 ? 128 : kind == 1 ? 256 : kind == 2 ? 512 : 320;
    for (int c = tid; c < ncol; c += NTHREADS) {
        int oc;
        if (kind == 0) oc = 1552 + hq * 128 + c; else if (kind == 1) oc = (c < 128) ? (1552 + 1024 + kvh * 128 + c) : (1552 + 1280 + kvh * 128 + (c - 128));
        else if (kind == 2) oc = 3088 + c; else oc = 3088 + 512 + c;
        float a = 0.f; for (int k = 0; k < D; ++k) a += hv[k] * win[(size_t)k * INW + oc];
        zv[c] = a; }
    __syncthreads();
    float err = 0.f, vmax = 0.f;
    auto blockmax = [&](float v) { red[tid] = v; __syncthreads(); for (int o = 256; o > 0; o >>= 1) { if (tid < o) red[tid] = fmaxf(red[tid], red[tid + o]); __syncthreads(); } const float r = red[0]; __syncthreads(); return r; };
    auto blocksum = [&](float v) { red[tid] = v; __syncthreads(); for (int o = 256; o > 0; o >>= 1) { if (tid < o) red[tid] += red[tid + o]; __syncthreads(); } const float r = red[0]; __syncthreads(); return r; };
    if (kind == 0 || kind == 1) {
        const float* g = (kind == 0) ? CIN(IN_BQN) + l * 128 : CIN(IN_BKN) + l * 128;
        const float ss = blocksum(tid < 128 ? zv[tid] * zv[tid] : 0.f);
        const float rinv = rsqrtf(ss / 128.f + RMS_EPS);
        if (tid < 128) tv[tid] = zv[tid] * rinv * g[tid];
        __syncthreads();
        float ref = 0.f, got = 0.f;
        if (tid < 128) { const int i = tid & 63; const float ang = prep_rope_ang(i, 32, prow, pcol), cs = cosf(ang), sn = sinf(ang);
            ref = lat ? ((tid < 64) ? tv[i] * cs - tv[i + 64] * sn : tv[i + 64] * cs + tv[i] * sn) : tv[tid];
            if (kind == 0) { ref *= 0.12751743f; got = bf2f(WSP(bf16, WS_QG)[(size_t)n * 1024 + hq * 128 + tid]); }
            else got = bf2f(WSP(bf16, WS_KG)[((size_t)(b * 2 + kvh) * SKV + pos) * 128 + tid]); }
        else if (kind == 1 && tid < 256) { ref = zv[tid]; got = bf2f(WSP(bf16, WS_VG)[((size_t)(b * 2 + kvh) * SKV + pos) * 128 + (tid - 128)]); }
        vmax = blockmax(fabsf(ref)); err = blockmax(fabsf(ref - got)) / fmaxf(vmax, 1e-20f);
    } else if (kind == 2) {
        const float ss = blocksum(zv[tid] * zv[tid]);
        const float rinv = rsqrtf(ss / 512.f + RMS_EPS);
        tv[tid] = zv[tid] * rinv * CIN(IN_CQN)[l * 512 + tid];
        __syncthreads();
        const float* wuq = CIN(IN_WUQ) + (size_t)l * 512 * 768;
        if (tid < 192) { float a = 0.f; for (int k = 0; k < 512; ++k) a += tv[k] * wuq[(size_t)k * 768 + hm * 192 + tid]; zv[tid] = a; }
        __syncthreads();
        float ref = 0.f, got = 0.f;
        if (tid < 192) { if (tid < 128) ref = zv[tid]; else { const int j = tid - 128, i = j & 31; const float ang = prep_rope_ang(i, 16, prow, pcol), cs = cosf(ang), sn = sinf(ang);
                ref = lat ? ((j < 32) ? zv[128 + i] * cs - zv[128 + i + 32] * sn : zv[128 + i + 32] * cs + zv[128 + i] * sn) : zv[tid]; }
            ref *= MLA_QS; got = bf2f(WSP(bf16, WS_QM)[(size_t)n * 768 + hm * 192 + tid]); }
        vmax = blockmax(fabsf(ref)); err = blockmax(fabsf(ref - got)) / fmaxf(vmax, 1e-20f);
    } else {
        const float ss = blocksum(tid < 256 ? zv[tid] * zv[tid] : 0.f);
        const float rinv = rsqrtf(ss / 256.f + RMS_EPS);
        if (tid < 256) tv[tid] = zv[tid] * rinv * CIN(IN_CKVN)[l * 256 + tid];
        __syncthreads();
        const float* wukv = CIN(IN_WUKV) + (size_t)l * 256 * 1024;
        float kvv = 0.f;
        if (tid < 256) { for (int k = 0; k < 256; ++k) kvv += tv[k] * wukv[(size_t)k * 1024 + hm * 256 + tid]; }
        float ref = 0.f, got = 0.f;
        if (tid < 128) { ref = kvv; got = bf2f(WSP(bf16, WS_KM)[((size_t)(b * 4 + hm) * SKV + pos) * 192 + tid]); }
        else if (tid < 256) { ref = kvv; got = bf2f(WSP(bf16, WS_VM)[((size_t)(b * 4 + hm) * SKV + pos) * 128 + (tid - 128)]); }
        else if (tid < 320) { const int j = tid - 256, i = j & 31; const float ang = prep_rope_ang(i, 16, prow, pcol), cs = cosf(ang), sn = sinf(ang);
            ref = lat ? ((j < 32) ? zv[256 + i] * cs - zv[256 + i + 32] * sn : zv[256 + i + 32] * cs + zv[256 + i] * sn) : zv[tid];
            got = bf2f(WSP(bf16, WS_KM)[((size_t)(b * 4 + hm) * SKV + pos) * 192 + 128 + j]); }
        vmax = blockmax(fabsf(ref)); err = blockmax(fabsf(ref - got)) / fmaxf(vmax, 1e-20f);
    }
    if (tid == 0) atomicMax((unsigned*)(C.ws + WS_CTL) + CW_CHK, __float_as_uint(err));
    __syncthreads();
}
#endif
struct Args { const float* in[29]; float* out; unsigned char* ws; int ph_lo, ph_hi; };
constexpr int NPHASE = 2 + 9 * DEPTH;

__global__ void __launch_bounds__(NTHREADS, 2) trunk_fwd(Args args) {
    extern __shared__ __attribute__((aligned(16))) unsigned char lds[];
    Ctx C;
    C.out = args.out; C.ws = args.ws; C.G = gridDim.x; C.blk = blockIdx.x;
    char* ldsg = (char*)lds;
    LAS unsigned char* ldsl = (LAS unsigned char*)lds;
    if (threadIdx.x < 64) ((LAS unsigned*)(ldsl + LDS_MISC))[threadIdx.x] = 0u;
    __syncthreads();
    unsigned* ctl = (unsigned*)(C.ws + WS_CTL);
    XcdBarrier bar; bar.bar = ctl + CW_BAR; bar.x = 0; bar.st = nullptr;
    const int lo = args.ph_lo, hi = args.ph_hi;
    if (hi - lo > 1) bar = xcd_barrier_post(ctl + CW_BAR, (volatile LAS unsigned*)(ldsl + LDS_MISC + 32));
#ifndef PHASE_MASK
#define PHASE_MASK 0x7ff
#endif
#define HASP(k) ((PHASE_MASK >> (k)) & 1)
#ifndef SUBMASK
#define SUBMASK 0xff
#endif
#ifdef PROBE_NOATT
#undef SUBMASK
#define SUBMASK 0x47
#endif
#define HASS(k) ((SUBMASK >> (k)) & 1)
#define IN(k) (lo <= (k) && (k) < hi)
#define SEAM(k) do { if (IN(k) && IN((k) + 1)) xcd_barrier(bar); } while (0)
    const int NGW = C.G * NWAVES;
#define GWID() (C.blk * NWAVES + __builtin_amdgcn_readfirstlane(opaque_tid() >> 6))
#define REPS(k) for (int rep_ = 0; rep_ < ((PROBE_REP == (k)) ? 2 : 1); ++rep_)
#define REPBAR(k) do { if (PROBE_REP == (k) && rep_ == 0 && hi - lo > 1) xcd_barrier(bar); } while (0)
#define SUBON(b) (rep_ == 0 || ((PROBE_REPSUB >> (b)) & 1))

    if (HASP(0) && IN(0)) REPS(0) { phase_pre0(C, ldsg); REPBAR(0); } SEAM(0);
    if (HASP(1) && IN(1)) REPS(1) { phase_pre1(C); REPBAR(1); } SEAM(1);
#pragma nounroll
    for (int l = 0; l < DEPTH; ++l) {
        const int P = 2 + 9 * l;
        if (HASP(2) && IN(P + 0)) REPS(2) {
            if (C.G == 256) {
                pg8::DenseOrder S; S.init(M, 15 * 256, D, C.G, C.blk);
                EpiStore E{WSP(bf16, WS_Z), ZW};
                pg8::gemm_phase<EpiStore, pg8::DenseOrder>(ldsl, WSP(bf16, WS_HB), WSP(bf16, WS_WIN) + (size_t)l * ZW * D, D, S, E);
                pg8::TailOrder S2{C.blk, 222, 34, 15, M / 256, D};
                EpiStoreHalf E2{WSP(bf16, WS_Z), ZW};
                pg8::gemm_phase<EpiStoreHalf, pg8::TailOrder, 1>(ldsl, WSP(bf16, WS_HB), WSP(bf16, WS_WIN) + (size_t)l * ZW * D, D, S2, E2);
            } else {
                pg8::DenseOrder S; S.init(M, ZW, D, C.G, C.blk);
                EpiStore E{WSP(bf16, WS_Z), ZW};
                pg8::gemm_phase<EpiStore, pg8::DenseOrder>(ldsl, WSP(bf16, WS_HB), WSP(bf16, WS_WIN) + (size_t)l * ZW * D, D, S, E);
            }
            REPBAR(2);
        } SEAM(P + 0);
        if (HASP(3) && IN(P + 1)) REPS(3) {
            if (SUBON(0)) post_rows(C, l);
            if (SUBON(1)) for (int u = C.blk; u < 2 * 4 * NCHUNK; u += C.G) mlstm_a_unit(C, l, u, ldsg);
            REPBAR(3);
        } SEAM(P + 1);
        if (HASP(4) && IN(P + 2)) REPS(4) {
            const bool win = (C.G == 256);
            if (HASS(0) && SUBON(0)) { if (win) mlstm_scan_window(C, 222, 34); else mlstm_scan(C); }
            if (HASS(1) && SUBON(1)) { pg8::DenseOrder S; if (win) S.init_window(M, 768, 512, C.blk, 222); else S.init(M, 768, 512, C.G, C.blk);
              EpiQmla E{WSP(bf16, WS_QM), WSP(float, WS_ROPE) + 12288};
              pg8::gemm_phase<EpiQmla, pg8::DenseOrder>(ldsl, WSP(bf16, WS_CQ), WSP(bf16, WS_WUQ) + (size_t)l * 768 * 512, 512, S, E); }
            if (HASS(2) && SUBON(2)) { pg8::DenseOrder S; if (win) S.init_window(M, 1024, 256, C.blk, 222); else S.init(M, 1024, 256, C.G, C.blk);
              EpiKVmla E{WSP(bf16, WS_KM), WSP(bf16, WS_VM)};
              pg8::gemm_phase<EpiKVmla, pg8::DenseOrder>(ldsl, WSP(bf16, WS_CKV), WSP(bf16, WS_WUKV) + (size_t)l * 1024 * 256, 256, S, E); }
            REPBAR(4);
        } SEAM(P + 2);
        if (HASP(5) && IN(P + 3)) REPS(5) {
#ifdef PROBE_NOATT
            { PHASE_IDS(); const int rows_t = (l == 0) ? M : NL;
              for (int n = C.blk * NWAVES + wave; n < rows_t; n += NGW) { bf16* mr = WSP(bf16, WS_MIX) + (size_t)n * D + 512;
                  for (int j = 0; j < 3; ++j) *(u32x4*)(mr + (lane + 64 * j) * 8) = (u32x4){0u, 0u, 0u, 0u}; } }
#endif
            bool gqa_fixed;
            { const float* gq = CIN(IN_BQN) + l * 128; const float* gk = CIN(IN_BKN) + l * 128; const int ln_ = opaque_tid() & 63;
              float mq = fmaxf(fabsf(gq[ln_]), fabsf(gq[64 + ln_])), mk = fmaxf(fabsf(gk[ln_]), fabsf(gk[64 + ln_]));
#define AMAX_STEP(MSK_) do { mq = fmaxf(mq, __int_as_float(__builtin_amdgcn_ds_swizzle(__float_as_int(mq), ((MSK_) << 10) | 0x1F))); mk = fmaxf(mk, __int_as_float(__builtin_amdgcn_ds_swizzle(__float_as_int(mk), ((MSK_) << 10) | 0x1F))); } while (0)
              AMAX_STEP(1); AMAX_STEP(2); AMAX_STEP(4); AMAX_STEP(8); AMAX_STEP(16);
#undef AMAX_STEP
              { auto rq = __builtin_amdgcn_permlane32_swap(__float_as_uint(mq), __float_as_uint(mq), false, false); mq = fmaxf(__uint_as_float(rq[0]), __uint_as_float(rq[1]));
                auto rk = __builtin_amdgcn_permlane32_swap(__float_as_uint(mk), __float_as_uint(mk), false, false); mk = fmaxf(__uint_as_float(rk[0]), __uint_as_float(rk[1])); }
              gqa_fixed = __builtin_amdgcn_readfirstlane((int)(11.313708f * 1.4426950f * mq * mk < 60.f)) != 0; }
            const int fslot = (C.blk >> 3) & 3, fb0 = (l == 0 && C.G == 256) ? 16 : 0, fnb = (l == 0 && C.G == 256) ? 216 : C.G;
#define FILL_AT(s_) do { if (SUBON(0) && fslot == (s_) && C.blk >= fb0 && C.blk < fb0 + fnb) { __syncthreads(); fill_finish(C, ldsg, l, fb0, fnb); __syncthreads(); } } while (0)
            FILL_AT(0);
            if (HASS(3) && SUBON(0)) for (int u0 = C.blk; u0 < 2 * 4 * 32; u0 += C.G) { const int u = (C.G == 256) ? ((u0 & 7) * 32 + (u0 >> 3)) : u0;
                const int qb = u & 31, h = (u >> 5) & 3, b = u >> 7;
                if (!att::attn_body<192, 768, 192, D, 1, 2, 2>(WSP(bf16, WS_QM) + ((size_t)(b * T + qb * 256)) * 768 + h * 192, WSP(bf16, WS_KM) + (size_t)(b * 4 + h) * SKV * 192,
                    WSP(bf16, WS_VM) + (size_t)(b * 4 + h) * SKV * 128, WSP(bf16, WS_MIX) + ((size_t)(b * T + qb * 256)) * D + 1536 + h * 128, SKV, ldsg))
                    att::attn_body<192, 768, 192, D, 1, 1>(WSP(bf16, WS_QM) + ((size_t)(b * T + qb * 256)) * 768 + h * 192, WSP(bf16, WS_KM) + (size_t)(b * 4 + h) * SKV * 192,
                        WSP(bf16, WS_VM) + (size_t)(b * 4 + h) * SKV * 128, WSP(bf16, WS_MIX) + ((size_t)(b * T + qb * 256)) * D + 1536 + h * 128, SKV, ldsg); }
            FILL_AT(1);
            if (HASS(4) && SUBON(1)) for (int u0 = C.blk; u0 < 2 * 8 * 32; u0 += C.G) { int u = u0;
                if (C.G == 256) { const int c = u0 & 255, rnd = u0 >> 8, x = c & 7, pr = x >> 1, il = (c >> 3) * 2 + (x & 1) + 64 * rnd; u = pr * 128 + il; }
                const int qb = u & 31, h = (u >> 5) & 7, b = u >> 8;
                if (gqa_fixed) att::attn_body<128, 1024, 128, D, 1, 2, 135>(WSP(bf16, WS_QG) + ((size_t)(b * T + qb * 256)) * 1024 + h * 128, WSP(bf16, WS_KG) + (size_t)(b * 2 + (h >> 2)) * SKV * 128,
                    WSP(bf16, WS_VG) + (size_t)(b * 2 + (h >> 2)) * SKV * 128, WSP(bf16, WS_MIX) + ((size_t)(b * T + qb * 256)) * D + 512 + h * 128, SKV, ldsg);
                else att::attn_body<128, 1024, 128, D, 2, 1>(WSP(bf16, WS_QG) + ((size_t)(b * T + qb * 256)) * 1024 + h * 128, WSP(bf16, WS_KG) + (size_t)(b * 2 + (h >> 2)) * SKV * 128,
                    WSP(bf16, WS_VG) + (size_t)(b * 2 + (h >> 2)) * SKV * 128, WSP(bf16, WS_MIX) + ((size_t)(b * T + qb * 256)) * D + 512 + h * 128, SKV, ldsg); }
            FILL_AT(2);
            if (HASS(5) && SUBON(2) && l < DEPTH - 1) {
                for (int u = C.G - 1 - C.blk; u < 2 * 4; u += C.G) { const int h = u & 3, b = u >> 2;
                    att::attn_body<192, 768, 192, D, 1, 1>(WSP(bf16, WS_QM) + ((size_t)(NL + b * CTXL)) * 768 + h * 192, WSP(bf16, WS_KM) + (size_t)(b * 4 + h) * SKV * 192,
                        WSP(bf16, WS_VM) + (size_t)(b * 4 + h) * SKV * 128, WSP(bf16, WS_MIX) + ((size_t)(NL + b * CTXL)) * D + 1536 + h * 128, CTXL, ldsg); }
                for (int u = C.G - 9 - C.blk; u < 2 * 8; u += C.G) { if (u < 0) continue; const int h = u & 7, b = u >> 3;
                    att::attn_body<128, 1024, 128, D, 2, 1>(WSP(bf16, WS_QG) + ((size_t)(NL + b * CTXL)) * 1024 + h * 128, WSP(bf16, WS_KG) + (size_t)(b * 2 + (h >> 2)) * SKV * 128,
                        WSP(bf16, WS_VG) + (size_t)(b * 2 + (h >> 2)) * SKV * 128, WSP(bf16, WS_MIX) + ((size_t)(NL + b * CTXL)) * D + 512 + h * 128, CTXL, ldsg); }
            }
            if (HASS(6) && SUBON(3)) for (int u = C.blk; u < 2 * 4 * NCHUNK; u += C.G) { if (l == DEPTH - 1 && (u % NCHUNK) < 2) continue; mlstm_c_unit(C, l, u, ldsg); }
            FILL_AT(3);
#undef FILL_AT
            REPBAR(5);
        } SEAM(P + 3);
#ifdef PROBE_ATTCHK
        if (l == 0 && hi - lo > 1) { att_check(C, ldsg, PROBE_ATTCHK == 1); }
#endif
#ifdef PROBE_PREPCHK
        if (l == PROBE_PREPCHK - 1 && hi - lo > 1) { prep_check(C, ldsg, l); }
#endif
        if (HASP(6) && IN(P + 4)) REPS(6) {
            pg8::DenseOrder S; S.init((l == 0) ? M : NL, D, D, C.G, C.blk);
            EpiStore E{WSP(bf16, WS_Y), D};
            pg8::gemm_phase<EpiStore, pg8::DenseOrder>(ldsl, WSP(bf16, WS_MIX), WSP(bf16, WS_WOUT) + (size_t)l * D * D, D, S, E);
            REPBAR(6);
        } SEAM(P + 4);
        if (HASP(7) && IN(P + 5)) { phase_ln1(C, l, ldsg); } SEAM(P + 5);
        if (HASP(8) && IN(P + 6)) REPS(8) {
            moe_tables(C, l, ldsg);
            MoeOrder1 S{C.G, C.blk, (const LAS int*)(ldsl + LDS_MISC + 64), (const LAS int*)(ldsl + LDS_MISC + 136), WSP(int, WS_LIST), (C.G == 256) ? 2 : (1 << 30)};
            EpiGLU E{WSP(bf16, WS_HID), WSP(float, WS_ROWW), (const LAS int*)(ldsl + LDS_MISC + 136)};
            pg8::gemm_phase<EpiGLU, MoeOrder1>(ldsl, WSP(bf16, WS_HB), wgu_base(C, l), D, S, E);
            if (C.G == 256) {
                MoeOrder1Tail S2{C.G, C.blk, (const LAS int*)(ldsl + LDS_MISC + 64), (const LAS int*)(ldsl + LDS_MISC + 136), WSP(int, WS_LIST)};
                EpiGLUHalf E2{WSP(bf16, WS_HID), WSP(float, WS_ROWW), (const LAS int*)(ldsl + LDS_MISC + 136)};
                pg8::gemm_phase<EpiGLUHalf, MoeOrder1Tail, 2>(ldsl, WSP(bf16, WS_HB), wgu_base(C, l), D, S2, E2);
            }
            REPBAR(8);
        } SEAM(P + 6);
        if (HASP(9) && IN(P + 7)) REPS(9) {
            moe_tables(C, l, ldsg);
            MoeOrder2 S{C.G, C.blk, (const LAS int*)(ldsl + LDS_MISC + 64), (C.G == 256) ? 4 : (1 << 30)};
            EpiStore E{WSP(bf16, WS_FSLOT), D};
            pg8::gemm_phase<EpiStore, MoeOrder2>(ldsl, WSP(bf16, WS_HID), wd_base(C, l), DEXP, S, E);
            if (C.G == 256) {
                MoeOrder2Tail S2{C.G, C.blk, (const LAS int*)(ldsl + LDS_MISC + 64)};
                EpiStoreHalfM E2{WSP(bf16, WS_FSLOT), D};
                pg8::gemm_phase<EpiStoreHalfM, MoeOrder2Tail, 2>(ldsl, WSP(bf16, WS_HID), wd_base(C, l), DEXP, S2, E2);
            }
            REPBAR(9);
        } SEAM(P + 7);
        if (HASP(10) && IN(P + 8)) { moe_tables(C, l, ldsg); phase_ln2(C, l, ldsg); } SEAM(P + 8);
    }
#if defined(PROBE_ATTCHK) || defined(PROBE_PREPCHK)
    if (hi - lo > 1) { xcd_barrier(bar);
        if (C.blk == 0 && threadIdx.x == 0) { const float e = __uint_as_float(__hip_atomic_load((unsigned*)(C.ws + WS_CTL) + CW_CHK, __ATOMIC_RELAXED, __HIP_MEMORY_SCOPE_AGENT));
            C.out[0] += sqrtf(fminf(e, 10.f) * 1e-2f * (float)(NL) * (float)D); } }
#endif
#undef IN
#undef SEAM
}

extern "C" void kernel_launch(void* const* d_in, const int* in_sizes, int n_in, void* d_out, int out_size, void* d_ws, size_t ws_size, hipStream_t stream) {
    static int grid = 0;
    if (grid == 0) {
        if (n_in != 29 || in_sizes[0] != NL * D || out_size != NL * D || ws_size < WS_END) {
            fprintf(stderr, "kernel_launch: shape mismatch: n_in %d in0 %d out %d ws %zu (need %zu)\n", n_in, n_in > 0 ? in_sizes[0] : -1, out_size, ws_size, (size_t)WS_END); grid = -1; return; }
        int dev = 0, cus = 0, per_cu = 0;
        if (hipGetDevice(&dev) != hipSuccess || hipDeviceGetAttribute(&cus, hipDeviceAttributeMultiprocessorCount, dev) != hipSuccess) { grid = -1; return; }
        if (hipFuncSetAttribute((const void*)trunk_fwd, hipFuncAttributeMaxDynamicSharedMemorySize, LDS_BYTES) != hipSuccess) { fprintf(stderr, "kernel_launch: hipFuncSetAttribute failed\n"); grid = -1; return; }
        if (hipOccupancyMaxActiveBlocksPerMultiprocessor(&per_cu, (const void*)trunk_fwd, NTHREADS, LDS_BYTES) != hipSuccess || per_cu < 1) { fprintf(stderr, "kernel_launch: occupancy query reports %d\n", per_cu); }
        (void)hipGetLastError();
        grid = cus;
        if (grid < 235) { fprintf(stderr, "kernel_launch: %d CUs; the LN1 phase is laid out for >= 235 workgroups (<= 72 rows each)\n", grid); grid = -1; return; }
    }
    if (grid < 0) return;
    (void)hipMemsetAsync((char*)d_ws + WS_CTL, 0, CTL_BYTES, stream);
    Args a{};
    for (int i = 0; i < 29; ++i) a.in[i] = (const float*)d_in[i];
    a.out = (float*)d_out; a.ws = (unsigned char*)d_ws;
#if MK_N_LAUNCHES == 1
    a.ph_lo = 0; a.ph_hi = NPHASE;
    hipLaunchKernelGGL(trunk_fwd, dim3(grid), dim3(NTHREADS), LDS_BYTES, stream, a);
#else
    for (int p = 0; p < NPHASE; ++p) { a.ph_lo = p; a.ph_hi = p + 1; hipLaunchKernelGGL(trunk_fwd, dim3(grid), dim3(NTHREADS), LDS_BYTES, stream, a); }
#endif
    const hipError_t le = hipPeekAtLastError();
    if (le != hipSuccess) fprintf(stderr, "kernel_launch: launch failed: %s\n", hipGetErrorName(le));
}
```
